# Optimizing an MI355X kernel written in HIP

```python
import math
import jax, jax.numpy as jnp
from jax import lax
import numpy as np

D_MODEL = 1024
BATCH = 4
SEQ = 8192
DEPTH = 1

MIX_WIDTH = D_MODEL
POOL_WIDTH = MIX_WIDTH // 2
POOL_WINDOWS = (2, 4, 8, 16)
N_POOL_GROUPS = len(POOL_WINDOWS)
POOL_GROUP_WIDTH = POOL_WIDTH // N_POOL_GROUPS
ATTN_WIDTH = MIX_WIDTH - POOL_WIDTH
SB_HEAD_DIM = 64
SB_HEADS = ATTN_WIDTH // SB_HEAD_DIM
Q_BLOCK = 128
IN_WIDTH = POOL_WIDTH + 3 * ATTN_WIDTH
MEM_LEN = 256
MEM_HEADS = 4
MEM_HEAD_DIM = D_MODEL // MEM_HEADS
N_GROUPS = 4
EXPERTS_PER_GROUP = 4
N_EXPERTS = N_GROUPS * EXPERTS_PER_GROUP
TOP_K_EXPERT = 2
EXPERT_FF = D_MODEL // 2
RMS_EPS = 1e-6

kernel_name = "hybrid_pool_stickbreak_hmoe_layer"


def rms_norm(x, gain):
    xf = x.astype(jnp.float32)
    y = xf * lax.rsqrt(jnp.mean(xf * xf, axis=-1, keepdims=True) + RMS_EPS)
    return (y * gain.astype(jnp.float32)).astype(x.dtype)


def causal_multiscale_pool(u, w_pool, pool_scale):
    S = u.shape[1]
    t = jnp.arange(S)
    groups = jnp.split(u, N_POOL_GROUPS, axis=-1)
    outs = []
    for g, (ug, w) in enumerate(zip(groups, POOL_WINDOWS)):
        uf = ug.astype(jnp.float32)
        prefix = jnp.pad(jnp.cumsum(uf, axis=1), ((0, 0), (1, 0), (0, 0)))
        upper = prefix[:, 1:]
        lower = jnp.pad(prefix, ((0, 0), (w - 1, 0), (0, 0)))[:, :S]
        count = jnp.minimum(t + 1, w).astype(jnp.float32)[None, :, None]
        pooled = (upper - lower) / count - uf
        outs.append(jnp.einsum('bsc,cd->bsd', pooled.astype(u.dtype), w_pool[g]))
    return jnp.concatenate(outs, axis=-1) * pool_scale


def stick_breaking_attention(q, k, v):
    B, H, S, dh = q.shape
    n_blocks = S // Q_BLOCK
    scale = 1.0 / math.sqrt(dh)
    q_blocks = jnp.moveaxis(q.reshape(B, H, n_blocks, Q_BLOCK, dh), 2, 0)
    s_idx = jnp.arange(S)

    def one_block(args):
        qb, blk = args
        z = jnp.einsum('bhqd,bhkd->bhqk', qb, k).astype(jnp.float32) * scale
        t_idx = blk * Q_BLOCK + jnp.arange(Q_BLOCK)
        causal = s_idx[None, :] < t_idx[:, None]
        log_not = jnp.where(causal, jax.nn.log_sigmoid(-z), 0.0)
        suffix = lax.cumsum(log_not, axis=3, reverse=True) - log_not
        weights = jnp.where(causal, jnp.exp(jax.nn.log_sigmoid(z) + suffix), 0.0)
        return jnp.einsum('bhqk,bhkd->bhqd', weights.astype(v.dtype), v)

    out = lax.map(one_block, (q_blocks, jnp.arange(n_blocks)))
    return jnp.moveaxis(out, 0, 2).reshape(B, H, S, dh)


def memory_cross_attention(xn, memn, w_q, w_k, w_v, w_o):
    B, S, D = xn.shape
    q = jnp.einsum('bsd,de->bse', xn, w_q).reshape(B, S, MEM_HEADS, MEM_HEAD_DIM)
    k = jnp.einsum('bmd,de->bme', memn, w_k).reshape(B, -1, MEM_HEADS, MEM_HEAD_DIM)
    v = jnp.einsum('bmd,de->bme', memn, w_v).reshape(B, -1, MEM_HEADS, MEM_HEAD_DIM)
    s = jnp.einsum('bshd,bmhd->bhsm', q, k).astype(jnp.float32) / math.sqrt(MEM_HEAD_DIM)
    p = jax.nn.softmax(s, axis=-1).astype(v.dtype)
    o = jnp.einsum('bhsm,bmhd->bshd', p, v).reshape(B, S, D)
    return jnp.einsum('bse,ed->bsd', o, w_o)


def hierarchical_moe(x, w_group, w_expert, w_gate, w_up, w_down):
    B, S, D = x.shape
    xf = x.reshape(-1, D)
    g_prob = jax.nn.softmax(jnp.einsum('nd,dg->ng', xf, w_group).astype(jnp.float32), axis=-1)
    g_gate, g_idx = lax.top_k(g_prob, 1)
    e_logits = jnp.einsum('nd,de->ne', xf, w_expert).astype(jnp.float32)
    e_logits = e_logits.reshape(-1, N_GROUPS, EXPERTS_PER_GROUP)
    e_logits = jnp.take_along_axis(e_logits, g_idx[:, :, None], axis=1)[:, 0]
    e_prob = jax.nn.softmax(e_logits, axis=-1)
    e_w, e_idx = lax.top_k(e_prob, TOP_K_EXPERT)
    e_w = e_w / jnp.sum(e_w, axis=-1, keepdims=True)
    weights = g_gate * e_w
    expert_ids = g_idx * EXPERTS_PER_GROUP + e_idx
    combine = jnp.einsum('nk,nke->ne', weights,
                         jax.nn.one_hot(expert_ids, N_EXPERTS, dtype=jnp.float32))
    y = jnp.zeros(xf.shape, jnp.float32)
    for e in range(N_EXPERTS):
        h = jax.nn.silu(xf @ w_gate[e]) * (xf @ w_up[e])
        y = y + combine[:, e:e + 1] * (h @ w_down[e]).astype(jnp.float32)
    return y.astype(x.dtype).reshape(B, S, D)


def setup_inputs(seed: int = 0) -> dict:
    key = jax.random.key(seed)
    ks = jax.random.split(key, 20)
    f32 = jnp.float32

    def nrm(k, shape, fan_in):
        return jax.random.normal(k, shape, f32) * (fan_in ** -0.5)

    def gain(k, shape):
        return 1.0 + 0.02 * jax.random.normal(k, shape, f32)

    L = DEPTH
    return {
        "x": jax.random.normal(ks[0], (BATCH, SEQ, D_MODEL), f32),
        "mem": jax.random.normal(ks[1], (BATCH, MEM_LEN, D_MODEL), f32),
        "norm_mix": gain(ks[2], (L, D_MODEL)),
        "w_in": nrm(ks[3], (L, D_MODEL, IN_WIDTH), D_MODEL),
        "w_pool": nrm(ks[4], (L, N_POOL_GROUPS, POOL_GROUP_WIDTH, POOL_GROUP_WIDTH), POOL_GROUP_WIDTH),
        "pool_scale": gain(ks[5], (L, POOL_WIDTH)),
        "w_out": nrm(ks[6], (L, MIX_WIDTH, D_MODEL), MIX_WIDTH),
        "norm_cross": gain(ks[7], (L, D_MODEL)),
        "norm_mem": gain(ks[8], (L, D_MODEL)),
        "w_q_mem": nrm(ks[9], (L, D_MODEL, D_MODEL), D_MODEL),
        "w_k_mem": nrm(ks[10], (L, D_MODEL, D_MODEL), D_MODEL),
        "w_v_mem": nrm(ks[11], (L, D_MODEL, D_MODEL), D_MODEL),
        "w_o_mem": nrm(ks[12], (L, D_MODEL, D_MODEL), D_MODEL),
        "norm_ffn": gain(ks[13], (L, D_MODEL)),
        "w_group": nrm(ks[14], (L, D_MODEL, N_GROUPS), D_MODEL),
        "w_expert": nrm(ks[15], (L, D_MODEL, N_EXPERTS), D_MODEL),
        "w_gate": nrm(ks[16], (L, N_EXPERTS, D_MODEL, EXPERT_FF), D_MODEL),
        "w_up": nrm(ks[17], (L, N_EXPERTS, D_MODEL, EXPERT_FF), D_MODEL),
        "w_down": nrm(ks[18], (L, N_EXPERTS, EXPERT_FF, D_MODEL), EXPERT_FF),
        "norm_final": gain(ks[19], (D_MODEL,)),
    }


def reference(x, mem, norm_mix, w_in, w_pool, pool_scale, w_out, norm_cross, norm_mem,
              w_q_mem, w_k_mem, w_v_mem, w_o_mem, norm_ffn, w_group, w_expert,
              w_gate, w_up, w_down, norm_final):
    B, S, D = x.shape
    h = x
    for layer in range(DEPTH):
        xn = rms_norm(h, norm_mix[layer])
        proj = jnp.einsum('bsd,de->bse', xn, w_in[layer])
        u_pool = proj[..., :POOL_WIDTH]
        q, k, v = jnp.split(proj[..., POOL_WIDTH:], 3, axis=-1)
        to_heads = lambda t: jnp.transpose(t.reshape(B, S, SB_HEADS, SB_HEAD_DIM), (0, 2, 1, 3))
        pool_out = causal_multiscale_pool(u_pool, w_pool[layer], pool_scale[layer])
        attn_out = stick_breaking_attention(to_heads(q), to_heads(k), to_heads(v))
        attn_out = jnp.transpose(attn_out, (0, 2, 1, 3)).reshape(B, S, ATTN_WIDTH)
        mixed = jnp.concatenate([pool_out, attn_out], axis=-1)
        h = h + jnp.einsum('bse,ed->bsd', mixed, w_out[layer])
        h = h + memory_cross_attention(rms_norm(h, norm_cross[layer]), rms_norm(mem, norm_mem[layer]),
                                       w_q_mem[layer], w_k_mem[layer], w_v_mem[layer], w_o_mem[layer])
        h = h + hierarchical_moe(rms_norm(h, norm_ffn[layer]), w_group[layer], w_expert[layer],
                                 w_gate[layer], w_up[layer], w_down[layer])
    return rms_norm(h, norm_final)
```

```cpp
#include <hip/hip_runtime.h>
#include <cstdio>
#include <cstdint>

#ifndef MK_N_LAUNCHES
#define MK_N_LAUNCHES 1
#endif

#define LAS __attribute__((address_space(3)))
#define GAS __attribute__((address_space(1)))
typedef unsigned short bf16_t;
typedef short bf16x8 __attribute__((ext_vector_type(8)));
typedef float f32x2 __attribute__((ext_vector_type(2)));
typedef float f32x4 __attribute__((ext_vector_type(4)));
typedef float f32x16 __attribute__((ext_vector_type(16)));
typedef unsigned u32x2 __attribute__((ext_vector_type(2)));
typedef unsigned u32x4 __attribute__((ext_vector_type(4)));
typedef __bf16 bf16x2_t __attribute__((ext_vector_type(2)));
typedef GAS unsigned gu32;

constexpr int NTOK = 32768, SEQ = 8192, NB = 4, D = 1024;
constexpr int INW = 2048;
constexpr int QKU_LD = 1536;
constexpr int MEMROWS = 1024;
constexpr int NCOMBO = 24;
constexpr float RMS_EPS = 1e-6f;
constexpr float LOG2E = 1.4426950408889634f;
constexpr float QSCALE_SB = 0.125f * LOG2E;
constexpr float QSCALE_MEM = 0.0625f * LOG2E;

constexpr size_t MiB = 1u << 20;
constexpr size_t WS_CTL = 0, CTL_ZERO_BYTES = 1 * MiB;
constexpr size_t WS_WIN = 2 * MiB;
constexpr size_t WS_WOUT = 6 * MiB;
constexpr size_t WS_WQ = 8 * MiB;
constexpr size_t WS_WKV = 10 * MiB;
constexpr size_t WS_WO = 14 * MiB;
constexpr size_t WS_GU = 16 * MiB;
constexpr size_t WS_WD = 48 * MiB;
constexpr size_t WS_WP = 64 * MiB;
constexpr size_t WS_WR = 64 * MiB + 256 * 1024;
constexpr size_t WS_MEMN = 65 * MiB;
constexpr size_t WS_KMEM = 67 * MiB;
constexpr size_t WS_VMT = 69 * MiB;
constexpr size_t WS_SS1 = 72 * MiB;
constexpr size_t WS_SS2 = 74 * MiB;
constexpr size_t WS_SS3 = 76 * MiB;
constexpr size_t WS_RINFO = 80 * MiB;
constexpr size_t WS_RA = 96 * MiB;
constexpr size_t WS_RB = 160 * MiB;
constexpr size_t WS_END = 288 * MiB;
constexpr size_t WS_VT = WS_RB + 96 * MiB;
constexpr size_t WS_OC = WS_RB + 64 * MiB;
constexpr int CW_TMO = 0;
constexpr int CW_QUEUE = 64;
constexpr int CW_CNT = 256;
constexpr int CW_BAR = 4096;

constexpr int RING_BYTES = 131072;
constexpr int LDSCTL_OFF = RING_BYTES;
constexpr int LDS_BYTES = 147456;
constexpr int MW_BAR = 8, MW_CNT = 16, MW_TP = 40;

constexpr int NWAVES = 8;

#define LDS_WAIT() asm volatile("s_waitcnt lgkmcnt(0)" ::: "memory")
#define VM_WAIT() asm volatile("s_waitcnt vmcnt(0)" ::: "memory")
#define RLX_AGENT __ATOMIC_RELAXED, __HIP_MEMORY_SCOPE_AGENT

__device__ __forceinline__ unsigned f2bf(float f) { unsigned u = __builtin_bit_cast(unsigned, f); return (u + 0x7fffu + ((u >> 16) & 1u)) >> 16; }
__device__ __forceinline__ unsigned pk2(float lo, float hi) { return f2bf(lo) | (f2bf(hi) << 16); }
__device__ __forceinline__ unsigned cvtpk(float lo, float hi) { f32x2 v = {lo, hi}; bf16x2_t b = __builtin_convertvector(v, bf16x2_t); return __builtin_bit_cast(unsigned, b); }
__device__ __forceinline__ float bflo(unsigned w) { return __builtin_bit_cast(float, w << 16); }
__device__ __forceinline__ float bfhi(unsigned w) { return __builtin_bit_cast(float, w & 0xffff0000u); }
__device__ __forceinline__ float wave_sum(float v) {
#pragma unroll
    for (int o = 1; o < 64; o <<= 1) v += __shfl_xor(v, o);
    return v;
}
#define MFMA32(a, b, c) __builtin_amdgcn_mfma_f32_32x32x16_bf16((a), (b), (c), 0, 0, 0)

namespace pg8 {
constexpr int BM = 256, BK = 64, HALF = 128, HTB = HALF * BK * 2, STAGE_BYTES = 8 * HTB, NXCD = 8, WGM = 8;
__host__ __device__ __forceinline__ int lds_byte(int r, int c) { const int st = (r >> 4) * 2 + (c >> 5), rr = r & 15, cc = c & 31, ob = rr * 64 + cc * 2; return st * 1024 + (ob ^ (((ob >> 9) & 1) << 5)); }
__host__ __device__ __forceinline__ void stage_rc(int b, int& R, int& C) { const int st = b / 1024, sb = b % 1024, swz = sb ^ (((sb >> 9) & 1) << 5); R = (st >> 1) * 16 + swz / 64; C = (st & 1) * 32 + (swz % 64) / 2; }
__host__ __device__ __forceinline__ int perm32(int rho) { const int n = rho >> 4, i = rho & 15; return 8 * (i >> 2) + 4 * n + (i & 3); }

struct Unit { const char* A; const char* B; char* O; int ldc; float scale; int pm, pn, flags, aux0, aux1, aux2; };

__device__ __forceinline__ void map_std(int nM, int nN, int L, int& pm, int& pn) {
    const int nwg = nM * nN; int wgid = L; { const int q = nwg / NXCD, r = nwg % NXCD, xcd = wgid % NXCD, off = wgid / NXCD; wgid = (xcd < r ? xcd * (q + 1) : r * (q + 1) + (xcd - r) * q) + off; }
    const int nig = WGM * nN, gid = wgid / nig, fm = gid * WGM, gsz = (nM - fm) < WGM ? (nM - fm) : WGM;
    pm = fm + ((wgid % nig) % gsz); pn = (wgid % nig) / gsz;
}

template <class Epi, class Sched, bool GATHER, bool ALIGN_EPI>
__device__ __forceinline__ void gemm_phase(LAS unsigned char* lds, const int lda, const int ldb, const int K, const Sched& S, const Epi& E) {
    const int tid = threadIdx.x, wid = __builtin_amdgcn_readfirstlane(tid >> 6), lane = tid & 63, wr = wid >> 2, wc = wid & 3, fr = lane & 15, fq = lane >> 4;
    const int nt = K / BK;
    int R0, C0; stage_rc(tid * 16, R0, C0);
    const int R1 = R0 + 64;
    const int Rb0 = (R0 & ~31) + perm32(R0 & 31), Rb1 = (R1 & ~31) + perm32(R1 & 31);
    unsigned voffB[2]; voffB[0] = (unsigned)(Rb0 * ldb + C0) * 2u; voffB[1] = (unsigned)(Rb1 * ldb + C0) * 2u;
    unsigned cvA[2][2];
    const size_t kstep = (size_t)(BK * 2);
    const size_t hstepB = (size_t)HALF * ldb * 2;
    const unsigned ldsw = (unsigned)wid * 1024u;
    const int aoff = lds_byte(wr * 64 + fr, fq * 8), boff = lds_byte(wc * 32 + fr, fq * 8);
#define PG8_SA(b, h) (((b) * 2 + (h)) * HTB)
#define PG8_SB(b, h) ((4 + (b) * 2 + (h)) * HTB)
#define PG8_STAGE(bufoff, gbase, voff) do { _Pragma("unroll") for (int _i = 0; _i < 2; ++_i) \
        __builtin_amdgcn_global_load_lds((const unsigned*)((const char*)(gbase) + (voff)[_i]), (LAS unsigned*)(lds + (bufoff) + ldsw + _i * 8192), 16, 0, 0); } while (0)
#define PG8_LDA(dst, b, h) do { _Pragma("unroll") for (int m = 0; m < 4; ++m) _Pragma("unroll") for (int k = 0; k < 2; ++k) dst[m][k] = *(const LAS bf16x8*)(lds + PG8_SA(b, h) + aoff + m * 2048 + k * 1024); } while (0)
#define PG8_LDB(dst, b, h) do { _Pragma("unroll") for (int n = 0; n < 2; ++n) _Pragma("unroll") for (int k = 0; k < 2; ++k) dst[n][k] = *(const LAS bf16x8*)(lds + PG8_SB(b, h) + boff + n * 2048 + k * 1024); } while (0)
#define PG8_MMA(ai, bj, At, Bt) do { __builtin_amdgcn_s_setprio(1); _Pragma("unroll") for (int m = 0; m < 4; ++m) _Pragma("unroll") for (int n = 0; n < 2; ++n) _Pragma("unroll") for (int k = 0; k < 2; ++k) \
        acc[ai][bj][m][n] = __builtin_amdgcn_mfma_f32_16x16x32_bf16(Bt[n][k], At[m][k], acc[ai][bj][m][n], 0, 0, 0); __builtin_amdgcn_s_setprio(0); } while (0)
#define PG8_WAIT_V(n) asm volatile("s_waitcnt vmcnt(" #n ")" ::: "memory")
#define PG8_WAIT_L(n) asm volatile("s_waitcnt lgkmcnt(" #n ")" ::: "memory")
#define PG8_BAR __builtin_amdgcn_s_barrier()
#define PG8_SCHED __builtin_amdgcn_sched_barrier(0)
#define PG8_TABLD(u, buf) do { if (wid < 4) { __builtin_amdgcn_global_load_lds(S.tokptr(u, wid * 64 + lane), (LAS unsigned*)(tokTab + (buf) * 256 + wid * 64), 4, 0, 0); } } while (0)
#define PG8_ROWOFF_G(dst, buf) do { const LAS int* _t = tokTab + (buf) * 256; \
        dst[0][0] = (unsigned)(_t[R0] * lda + C0) * 2u; dst[0][1] = (unsigned)(_t[R1] * lda + C0) * 2u; dst[1][0] = (unsigned)(_t[HALF + R0] * lda + C0) * 2u; dst[1][1] = (unsigned)(_t[HALF + R1] * lda + C0) * 2u; } while (0)
    LAS int* const tokTab = (LAS int*)(lds + STAGE_BYTES + 1024);
    Unit cur, nxt; int ui = 0;
    if (!S.next(0, cur)) return;
    f32x4 acc[2][2][4][2];
#pragma unroll
    for (int a = 0; a < 2; ++a)
#pragma unroll
        for (int b = 0; b < 2; ++b)
#pragma unroll
            for (int m = 0; m < 4; ++m)
#pragma unroll
                for (int n = 0; n < 2; ++n) acc[a][b][m][n] = (f32x4){0.f, 0.f, 0.f, 0.f};
    bf16x8 At[4][2], B0[2][2], B1[2][2];
    if constexpr (GATHER) { PG8_TABLD(cur, 0); PG8_WAIT_V(0); __syncthreads(); PG8_ROWOFF_G(cvA, 0); }
    else { cvA[0][0] = (unsigned)(R0 * lda + C0) * 2u; cvA[0][1] = (unsigned)(R1 * lda + C0) * 2u; cvA[1][0] = (unsigned)((HALF + R0) * lda + C0) * 2u; cvA[1][1] = (unsigned)((HALF + R1) * lda + C0) * 2u; }
    const char* cA = cur.A; const char* cB = cur.B;
    PG8_STAGE(PG8_SB(0, 0), cB, voffB); PG8_STAGE(PG8_SB(0, 1), cB + hstepB, voffB); PG8_STAGE(PG8_SA(0, 0), cA, cvA[0]); PG8_STAGE(PG8_SA(0, 1), cA, cvA[1]);
    if (wr == 1) PG8_BAR;
    PG8_WAIT_V(2); PG8_BAR;
    PG8_STAGE(PG8_SB(1, 0), cB + kstep, voffB); PG8_STAGE(PG8_SA(1, 0), cA + kstep, cvA[0]); PG8_STAGE(PG8_SB(1, 1), cB + hstepB + kstep, voffB);
    PG8_WAIT_V(6); PG8_BAR;
    for (;;) {
        const bool has_next = S.next(ui + 1, nxt);
        const char* nA = has_next ? nxt.A : cA; const char* nB = has_next ? nxt.B : cB;
        if constexpr (GATHER) { if (has_next) PG8_TABLD(nxt, (ui + 1) & 1); }
        for (int t = 0; t < nt; t += 2) {
            const bool last = (t == nt - 2);
            const char* a1 = cA + (size_t)(t + 1) * kstep;
            const char* a2 = last ? nA : cA + (size_t)(t + 2) * kstep; const char* b2 = last ? nB : cB + (size_t)(t + 2) * kstep;
            const char* a3 = a2 + kstep; const char* b3 = b2 + kstep;
            unsigned o2[2][2];
            o2[0][0] = cvA[0][0]; o2[0][1] = cvA[0][1]; o2[1][0] = cvA[1][0]; o2[1][1] = cvA[1][1];
            if constexpr (GATHER) { if (last && has_next) { PG8_ROWOFF_G(o2, (ui + 1) & 1); } }
            PG8_LDB(B0, 0, 0); PG8_LDB(B1, 0, 1); PG8_SCHED; PG8_LDA(At, 0, 0); PG8_STAGE(PG8_SA(1, 1), a1, cvA[1]);
            PG8_WAIT_V(8); PG8_WAIT_L(0); PG8_BAR; PG8_MMA(0, 0, At, B0); PG8_MMA(0, 1, At, B1); PG8_BAR; PG8_SCHED;
            PG8_LDA(At, 0, 1); PG8_STAGE(PG8_SB(0, 0), b2, voffB); PG8_STAGE(PG8_SB(0, 1), b2 + hstepB, voffB); PG8_STAGE(PG8_SA(0, 0), a2, o2[0]);
            PG8_WAIT_V(8); PG8_WAIT_L(0); PG8_BAR; PG8_MMA(1, 0, At, B0); PG8_MMA(1, 1, At, B1); PG8_BAR; PG8_SCHED;
            PG8_LDB(B0, 1, 0); PG8_LDB(B1, 1, 1); PG8_SCHED; PG8_LDA(At, 1, 0); PG8_STAGE(PG8_SA(0, 1), a2, o2[1]);
            PG8_WAIT_V(8); PG8_WAIT_L(0); PG8_BAR; PG8_MMA(0, 0, At, B0); PG8_MMA(0, 1, At, B1); PG8_BAR; PG8_SCHED;
            PG8_LDA(At, 1, 1); PG8_STAGE(PG8_SB(1, 0), b3, voffB); PG8_STAGE(PG8_SB(1, 1), b3 + hstepB, voffB); PG8_STAGE(PG8_SA(1, 0), a3, o2[0]);
            PG8_WAIT_V(8); PG8_WAIT_L(0); PG8_BAR; PG8_MMA(1, 0, At, B0); PG8_MMA(1, 1, At, B1); PG8_BAR; PG8_SCHED;
        }
        if constexpr (ALIGN_EPI) { if (wr == 0) PG8_BAR; }
        if (cur.flags & 2) E(acc, cur, wr, wc, fr, fq);
        if (!has_next) break;
        if (nxt.flags & 1) {
#pragma unroll
            for (int a = 0; a < 2; ++a)
#pragma unroll
                for (int b = 0; b < 2; ++b)
#pragma unroll
                    for (int m = 0; m < 4; ++m)
#pragma unroll
                        for (int n = 0; n < 2; ++n) acc[a][b][m][n] = (f32x4){0.f, 0.f, 0.f, 0.f};
        }
        cur = nxt; cA = nA; cB = nB; ++ui;
        if constexpr (GATHER) { PG8_ROWOFF_G(cvA, ui & 1); }
        if constexpr (ALIGN_EPI) { if (wr == 1) PG8_BAR; }
    }
    PG8_WAIT_V(0);
    if constexpr (!ALIGN_EPI) { if (wr == 0) PG8_BAR; }
    PG8_BAR;
#undef PG8_SA
#undef PG8_SB
#undef PG8_STAGE
#undef PG8_LDA
#undef PG8_LDB
#undef PG8_MMA
#undef PG8_WAIT_V
#undef PG8_WAIT_L
#undef PG8_BAR
#undef PG8_SCHED
#undef PG8_ROWOFF_G
#undef PG8_TABLD
}
}
using pg8::Unit;

#define XB_TMO      128
#define XB_XCNT(j)  (256  + 64 * (j))
#define XB_XSUB(j)  (1280 + 64 * (j))
#define XB_XGEN(j)  (2304 + 64 * (j))
#define XB_TOP      3328
#define XB_TOPGEN   3392
#define XCD_BAR_WORDS 3456
#define XB_SPIN_CAP (1u << 18)
__device__ __forceinline__ unsigned xb_ld(unsigned* p)              { return __hip_atomic_load(p, __ATOMIC_RELAXED, __HIP_MEMORY_SCOPE_AGENT); }
__device__ __forceinline__ unsigned xb_add(unsigned* p, unsigned v) { return __hip_atomic_fetch_add(p, v, __ATOMIC_RELAXED, __HIP_MEMORY_SCOPE_AGENT); }
__device__ __forceinline__ unsigned xb_xcc_id() { return (unsigned)__builtin_amdgcn_s_getreg((3 << 11) | 20) & 0xFu; }
#define XB_SPIN(cond, bar) do { unsigned _sp = 0; while (cond) { __builtin_amdgcn_s_sleep(1); \
    if ((++_sp & 255u) == 0u) { if (xb_ld(&(bar)[XB_TMO])) break; if (_sp > XB_SPIN_CAP) { atomicAdd(&(bar)[XB_TMO], 1u); break; } } } } while (0)
struct XcdBarrier { unsigned* bar; unsigned x; volatile LAS unsigned* st; };
__device__ __forceinline__ XcdBarrier xcd_barrier_post(unsigned* bar, volatile LAS unsigned* st) {
    XcdBarrier b; b.bar = bar; b.x = xb_xcc_id(); b.st = st;
    if (threadIdx.x == 0) (void)xb_add(&bar[XB_XCNT(b.x)], 1u);
    return b;
}
__device__ __forceinline__ void xcd_barrier_complete(unsigned* bar, unsigned x, unsigned& nloc, unsigned& nx) {
    const unsigned G = gridDim.x * gridDim.y * gridDim.z;
    unsigned sum, cnt, mine, sp = 0u;
    for (;;) {
        sum = 0u; cnt = 0u; mine = 0u;
#pragma unroll
        for (unsigned j = 0; j < 16; ++j) { const unsigned c = xb_ld(&bar[XB_XCNT(j)]); sum += c; cnt += (c > 0u) ? 1u : 0u; mine = (j == x) ? c : mine; }
        if (sum == G) break;
        __builtin_amdgcn_s_sleep(1);
        if ((++sp & 255u) == 0u) { if (xb_ld(&bar[XB_TMO])) break; if (sp > XB_SPIN_CAP) { atomicAdd(&bar[XB_TMO], 1u); break; } }
    }
    nloc = mine > 0u ? mine : 1u; nx = cnt > 0u ? cnt : 1u;
}
__device__ __forceinline__ void xcd_barrier(const XcdBarrier& b) {
    asm volatile("s_waitcnt vmcnt(0)" ::: "memory");
    __syncthreads();
    if (threadIdx.x == 0) {
        unsigned* bar = b.bar;
        __builtin_amdgcn_s_waitcnt(0);
        unsigned nloc = b.st[0], nx = b.st[1];
        if (nloc == 0u) { xcd_barrier_complete(bar, b.x, nloc, nx); b.st[0] = nloc; b.st[1] = nx; }
        const unsigned old = xb_add(&bar[XB_XSUB(b.x)], 1u);
        const unsigned gen = old / nloc;
        if (old + 1u == (gen + 1u) * nloc) {
            __builtin_amdgcn_fence(__ATOMIC_RELEASE, "agent");
            asm volatile("s_waitcnt vmcnt(0)" ::: "memory");
            const unsigned og = xb_add(&bar[XB_TOP], 1u);
            const unsigned tg = og / nx;
            if (og + 1u == (tg + 1u) * nx) xb_add(&bar[XB_TOPGEN], 1u);
            else XB_SPIN(xb_ld(&bar[XB_TOPGEN]) == tg, bar);
            __builtin_amdgcn_fence(__ATOMIC_ACQUIRE, "agent");
            xb_add(&bar[XB_XGEN(b.x)], 1u);
            asm volatile("s_waitcnt vmcnt(0)" ::: "memory");
        } else {
            XB_SPIN(xb_ld(&bar[XB_XGEN(b.x)]) == gen, bar);
            __builtin_amdgcn_fence(__ATOMIC_ACQUIRE, "agent");
            asm volatile("s_waitcnt vmcnt(0)" ::: "memory");
        }
    }
    __syncthreads();
}

struct Frame {
    LAS unsigned char* lds;
    volatile LAS unsigned* MISC;
    unsigned* ctl;
    int tid, lane, wave, vcu, G;
    unsigned char* ws;
};
enum { I_X = 0, I_MEM, I_NORM_MIX, I_W_IN, I_W_POOL, I_POOL_SCALE, I_W_OUT, I_NORM_CROSS, I_NORM_MEM, I_WQ, I_WK, I_WV, I_WO, I_NORM_FFN, I_W_GROUP, I_W_EXPERT, I_W_GATE, I_W_UP, I_W_DOWN, I_NORM_FINAL };

__device__ __forceinline__ void p0_transpose_item(const float* W, int ldw, int k0, int n0, const float* gain, bf16_t* dst, int ldd, LAS float* scr, int lane) {
#pragma unroll 8
    for (int i = 0; i < 32; ++i) { const int kk = 2 * i + (lane >> 5); float v = W[(size_t)(k0 + kk) * ldw + n0 + (lane & 31)]; if (gain) v *= gain[k0 + kk]; scr[kk * 33 + (lane & 31)] = v; }
    LDS_WAIT(); asm volatile("" ::: "memory");
    const int c = lane & 7;
#pragma unroll
    for (int j = 0; j < 4; ++j) { const int n = (lane >> 3) + 8 * j; const LAS float* s = scr + (8 * c) * 33 + n;
        u32x4 o; o.x = pk2(s[0 * 33], s[1 * 33]); o.y = pk2(s[2 * 33], s[3 * 33]); o.z = pk2(s[4 * 33], s[5 * 33]); o.w = pk2(s[6 * 33], s[7 * 33]);
        *(u32x4*)(dst + (size_t)n * ldd + 8 * c) = o; }
    LDS_WAIT(); asm volatile("" ::: "memory");
}
__device__ __forceinline__ void rms_row_to_bf16(const float* xrow, const float* gain, bf16_t* orow, int lane) {
    const f32x4* xr = (const f32x4*)xrow + lane; const f32x4* gr = (const f32x4*)gain + lane;
    f32x4 v[4]; float s = 0.f;
#pragma unroll
    for (int j = 0; j < 4; ++j) { v[j] = xr[64 * j]; s += (v[j].x * v[j].x + v[j].y * v[j].y) + (v[j].z * v[j].z + v[j].w * v[j].w); }
    const float r = 1.0f / sqrtf(wave_sum(s) * (1.f / D) + RMS_EPS);
    u32x2* o8 = (u32x2*)orow + lane;
#pragma unroll
    for (int j = 0; j < 4; ++j) { const f32x4 g = gr[64 * j]; u32x2 w; w.x = pk2(v[j].x * r * g.x, v[j].y * r * g.y); w.y = pk2(v[j].z * r * g.z, v[j].w * r * g.w); o8[64 * j] = w; }
}
__device__ __forceinline__ void p0_prologue(Frame& F, const float* const* in) {
    LAS float* scr = (LAS float*)(F.lds + F.wave * 16384);
    const int gw = F.vcu * NWAVES + F.wave, NGW = F.G * NWAVES;
    unsigned char* ws = F.ws;
    constexpr int I_IN = 16 * 64, I_SQ = 16 * 32, I_POOL = 4 * 2 * 4, I_GATE = 16 * 16 * 16, I_DOWN = 16 * 8 * 32;
    constexpr int NITEMS = I_IN + 5 * I_SQ + I_POOL + 2 * I_GATE + I_DOWN;
    for (int it = gw; it < NITEMS; it += NGW) {
        int r = it, src, gsrc = -1, ldw, k0, n0, ldd; size_t soff = 0, doff;
        if (r < I_IN) { const int kb = r / 64, nb = r % 64; src = I_W_IN; ldw = INW; k0 = 64 * kb; n0 = 32 * nb; ldd = D; doff = WS_WIN + ((size_t)n0 * D + k0) * 2; }
        else if ((r -= I_IN) < 5 * I_SQ) { const int which = r / I_SQ, q = r % I_SQ, kb = q / 32, nb = q % 32; ldw = D; k0 = 64 * kb; n0 = 32 * nb; ldd = D;
            src = which == 0 ? I_W_OUT : which == 1 ? I_WQ : which == 2 ? I_WK : which == 3 ? I_WV : I_WO; if (which == 1) gsrc = I_NORM_CROSS;
            const size_t base = which == 0 ? WS_WOUT : which == 1 ? WS_WQ : which == 2 ? WS_WKV : which == 3 ? WS_WKV + (size_t)1024 * D * 2 : WS_WO;
            doff = base + ((size_t)n0 * D + k0) * 2; }
        else if ((r -= 5 * I_SQ) < I_POOL) { const int g = r / 8, q = r % 8, kb = q / 4, nb = q % 4; src = I_W_POOL; soff = (size_t)g * 128 * 128; ldw = 128; k0 = 64 * kb; n0 = 32 * nb; ldd = 128;
            doff = WS_WP + ((size_t)g * 128 * 128 + (size_t)n0 * 128 + k0) * 2; }
        else if ((r -= I_POOL) < 2 * I_GATE) { const int up = r / I_GATE, q = r % I_GATE, e = q / 256, q2 = q % 256, kb = q2 / 16, nb = q2 % 16; src = up ? I_W_UP : I_W_GATE; gsrc = I_NORM_FFN;
            soff = (size_t)e * D * 512; ldw = 512; k0 = 64 * kb; n0 = 32 * nb; ldd = D; const int drow = (n0 >> 7) * 256 + up * 128 + (n0 & 127);
            doff = WS_GU + (((size_t)e * 1024 + drow) * D + k0) * 2; }
        else { r -= 2 * I_GATE; const int e = r / 256, q2 = r % 256, kb = q2 / 32, nb = q2 % 32; src = I_W_DOWN; soff = (size_t)e * 512 * D; ldw = D; k0 = 64 * kb; n0 = 32 * nb; ldd = 512;
            doff = WS_WD + (((size_t)e * 1024 + n0) * 512 + k0) * 2; }
        const float* W = in[src] + soff; const float* gain = gsrc >= 0 ? in[gsrc] : nullptr;
        p0_transpose_item(W, ldw, k0, n0, gain, (bf16_t*)(ws + doff), ldd, scr, F.lane);
    }
    {
        bf16_t* wr = (bf16_t*)(ws + WS_WR); const int gt = F.vcu * 512 + F.tid, NT = F.G * 512;
        for (int idx = gt; idx < 32 * D; idx += NT) { const int m = idx >> 10, k = idx & 1023; float v = 0.f;
            if (m < 4) v = in[I_W_GROUP][k * 4 + m] * in[I_NORM_FFN][k]; else if (m >= 8 && m < 24) v = in[I_W_EXPERT][k * 16 + (m - 8)] * in[I_NORM_FFN][k];
            const unsigned h = f2bf(v); const float hf = __builtin_bit_cast(float, h << 16); const unsigned l = f2bf(v - hf);
            wr[idx] = (bf16_t)h; wr[32 * D + idx] = (bf16_t)l; }
    }
    for (int m = gw; m < NTOK; m += NGW) rms_row_to_bf16(in[I_X] + (size_t)m * D, in[I_NORM_MIX], (bf16_t*)(ws + WS_RA) + (size_t)m * D, F.lane);
    for (int m = gw; m < MEMROWS; m += NGW) rms_row_to_bf16(in[I_MEM] + (size_t)m * D, in[I_NORM_MEM], (bf16_t*)(ws + WS_MEMN) + (size_t)m * D, F.lane);
}

struct SchedP1 {
    const char* XN; const char* WIN; char* QKU; char* VT; int G, c;
    __device__ __forceinline__ bool next(int i, Unit& u) const {
        const int L = i * G + c; if (L >= 1024) return false;
        u.flags = 3; u.aux0 = 0; u.aux1 = 0; u.aux2 = 0;
        if (L < 768) { int pm, pn; pg8::map_std(128, 6, L, pm, pn); u.pm = pm; u.pn = pn;
            u.A = XN + (size_t)pm * 256 * D * 2; u.B = WIN + (size_t)pn * 256 * D * 2; u.O = QKU + ((size_t)pm * 256 * QKU_LD + pn * 256) * 2; u.ldc = QKU_LD; u.scale = (pn == 2 || pn == 3) ? QSCALE_SB : 1.f; }
        else { const int l2 = L - 768, pm = l2 >> 7, pn = l2 & 127; u.pm = pm; u.pn = pn;
            u.A = WIN + (size_t)(1536 + pm * 256) * D * 2; u.B = XN + (size_t)pn * 256 * D * 2; u.O = VT + ((size_t)pm * 256 * NTOK + pn * 256) * 2; u.ldc = NTOK; u.scale = 1.f; }
        return true;
    }
};
struct SchedMemKV {
    const char* MEMN; const char* WKV; char* KMEM; char* VMT; int G, c;
    __device__ __forceinline__ bool next(int i, Unit& u) const {
        const int L = i * G + c; if (L >= 32) return false;
        u.flags = 3; u.aux0 = 0; u.aux1 = 0; u.aux2 = 0; u.ldc = 1024; u.scale = 1.f;
        const int l2 = L & 15, pm = l2 >> 2, pn = l2 & 3; u.pm = pm; u.pn = pn;
        if (L < 16) { u.A = MEMN + (size_t)pm * 256 * D * 2; u.B = WKV + (size_t)pn * 256 * D * 2; u.O = KMEM + ((size_t)pm * 256 * 1024 + pn * 256) * 2; }
        else { u.A = WKV + (size_t)(1024 + pm * 256) * D * 2; u.B = MEMN + (size_t)pn * 256 * D * 2; u.O = VMT + ((size_t)pm * 256 * 1024 + pn * 256) * 2; }
        return true;
    }
};
struct SchedStd {
    const char* A; const char* B; bf16_t* Obase; int G, c;
    __device__ __forceinline__ bool next(int i, Unit& u) const {
        const int L = i * G + c; if (L >= 512) return false;
        int pm, pn; pg8::map_std(128, 4, L, pm, pn); u.pm = pm; u.pn = pn; u.flags = 3; u.aux0 = 0; u.aux1 = 0; u.aux2 = 0; u.O = Obase ? (char*)(Obase + (size_t)pm * 256 * D + pn * 256) : nullptr; u.ldc = D; u.scale = 1.f;
        u.A = A + (size_t)pm * 256 * D * 2; u.B = B + (size_t)pn * 256 * D * 2; return true;
    }
};
__device__ __forceinline__ void moe_decode_tile(volatile LAS unsigned* MISC, int tile, int& c, int& lt, int& nvalid) {
    c = 0;
#pragma unroll 1
    for (int k = 1; k < NCOMBO; ++k) if ((int)MISC[MW_TP + k] <= tile) c = k;
    lt = tile - (int)MISC[MW_TP + c]; const int rem = (int)MISC[MW_CNT + c] - lt * 256; nvalid = rem < 256 ? rem : 256;
}
__device__ __forceinline__ int pair_lo(int p) { return p < 3 ? 0 : (p < 5 ? 1 : 2); }
__device__ __forceinline__ int pair_hi(int p) { return p < 3 ? p + 1 : (p < 5 ? p - 1 : 3); }
struct SchedP8 {
    volatile LAS unsigned* MISC; const char* H2; const char* GU; char* HH; const f32x4* RINFO; int G, c;
    __device__ __forceinline__ bool next(int i, Unit& u) const {
        const int L = i * G + c, T = (int)MISC[MW_TP + NCOMBO]; if (L >= T * 8) return false;
        const int tile = L >> 3, pn = L & 7; int cb, lt, nv; moe_decode_tile(MISC, tile, cb, lt, nv);
        const int g = cb / 6, p = cb % 6, s = pn >> 2, ch = pn & 3, e = 4 * g + (s ? pair_hi(p) : pair_lo(p));
        u.A = H2; u.B = GU + ((size_t)e * 1024 + ch * 256) * D * 2; u.O = HH + ((size_t)tile * 256 * D + s * 512 + ch * 128) * 2; u.ldc = D; u.scale = 1.f;
        u.pm = tile; u.pn = pn; u.flags = 3; u.aux0 = cb * NTOK + lt * 256; u.aux1 = nv; u.aux2 = s; return true;
    }
    __device__ __forceinline__ const unsigned* tokptr(const Unit& u, int r) const { const int rr = r < u.aux1 ? r : u.aux1 - 1; return (const unsigned*)(RINFO + (u.aux0 + rr)) + 3; }
};
struct SchedP9 {
    volatile LAS unsigned* MISC; const char* HH; const char* WD; int G, c;
    __device__ __forceinline__ bool next(int i, Unit& u) const {
        const int L = (i >> 1) * G + c, ks = i & 1, T = (int)MISC[MW_TP + NCOMBO]; if (L >= T * 4) return false;
        const int tile = L >> 2, pn = L & 3; int cb, lt, nv; moe_decode_tile(MISC, tile, cb, lt, nv);
        const int g = cb / 6, p = cb % 6, e = 4 * g + (ks ? pair_hi(p) : pair_lo(p));
        u.A = HH + ((size_t)tile * 256 * D + ks * 512) * 2; u.B = WD + ((size_t)e * 1024 + pn * 256) * 512 * 2; u.O = nullptr; u.ldc = D; u.scale = 1.f;
        u.pm = tile; u.pn = pn; u.flags = ks ? 2 : 1; u.aux0 = cb * NTOK + lt * 256; u.aux1 = nv; u.aux2 = ks; return true;
    }
};

__device__ __forceinline__ u32x4 ldg16(const void* base, unsigned off) { return *(const u32x4*)((const char*)base + off); }
__device__ __forceinline__ f32x4 ldg16f(const void* base, unsigned off) { return *(const f32x4*)((const char*)base + off); }
__device__ __forceinline__ void stg16(void* base, unsigned off, u32x4 v) { *(u32x4*)((char*)base + off) = v; }
__device__ __forceinline__ void stg16f(void* base, unsigned off, f32x4 v) { *(f32x4*)((char*)base + off) = v; }
__device__ __forceinline__ float sum16(const void* base, unsigned off) {
    const f32x4 a = ldg16f(base, off), b = ldg16f(base, off + 16), c = ldg16f(base, off + 32), d = ldg16f(base, off + 48);
    return ((a.x + a.y) + (a.z + a.w)) + ((b.x + b.y) + (b.z + b.w)) + ((c.x + c.y) + (c.z + c.w)) + ((d.x + d.y) + (d.z + d.w));
}
__device__ __forceinline__ u32x4 pack8(const f32x4 v0, const f32x4 v1) { u32x4 w; w.x = cvtpk(v0[0], v0[1]); w.y = cvtpk(v0[2], v0[3]); w.z = cvtpk(v1[0], v1[1]); w.w = cvtpk(v1[2], v1[3]); return w; }
__device__ __forceinline__ float sq8(const f32x4 v0, const f32x4 v1) { return (v0[0] * v0[0] + v0[1] * v0[1]) + (v0[2] * v0[2] + v0[3] * v0[3]) + (v1[0] * v1[0] + v1[1] * v1[1]) + (v1[2] * v1[2] + v1[3] * v1[3]); }
struct EpiStore {
    const float* ss; float rowmul;
    __device__ __forceinline__ void operator()(const f32x4 (&acc)[2][2][4][2], const Unit& u, int wr, int wc, int fr, int fq) const {
        const unsigned lcol = (unsigned)(wc * 32 + 8 * fq) * 2u;
#pragma unroll
        for (int ai = 0; ai < 2; ++ai)
#pragma unroll
            for (int m = 0; m < 4; ++m) { const int r = ai * 128 + wr * 64 + m * 16 + fr; float sc = u.scale;
                if (ss) { const float t = sum16(ss, (unsigned)(u.pm * 256 + r) * 64u); sc = rowmul / sqrtf(t * (1.f / D) + RMS_EPS); }
                const unsigned ro = (unsigned)(r * u.ldc) * 2u + lcol;
#pragma unroll
                for (int bj = 0; bj < 2; ++bj) stg16(u.O, ro + bj * 256, pack8(acc[ai][bj][m][0] * sc, acc[ai][bj][m][1] * sc)); }
    }
};
template <bool RESF32> struct EpiRes {
    const void* res; bf16_t* out; float* ss;
    __device__ __forceinline__ void operator()(const f32x4 (&acc)[2][2][4][2], const Unit& u, int wr, int wc, int fr, int fq) const {
        const int col0 = u.pn * 256 + wc * 32 + 8 * fq;
#pragma unroll
        for (int ai = 0; ai < 2; ++ai)
#pragma unroll
            for (int m = 0; m < 4; ++m) { const int grow = u.pm * 256 + ai * 128 + wr * 64 + m * 16 + fr; float sq = 0.f;
#pragma unroll
                for (int bj = 0; bj < 2; ++bj) { const unsigned eoff = (unsigned)(grow * D + col0 + bj * 128); f32x4 r0, r1;
                    if constexpr (RESF32) { r0 = ldg16f(res, eoff * 4u); r1 = ldg16f(res, eoff * 4u + 16u); }
                    else { const u32x4 w = ldg16(res, eoff * 2u); r0 = (f32x4){bflo(w.x), bfhi(w.x), bflo(w.y), bfhi(w.y)}; r1 = (f32x4){bflo(w.z), bfhi(w.z), bflo(w.w), bfhi(w.w)}; }
                    const f32x4 v0 = acc[ai][bj][m][0] + r0, v1 = acc[ai][bj][m][1] + r1;
                    sq += sq8(v0, v1);
                    stg16(out, eoff * 2u, pack8(v0, v1)); }
                sq += __shfl_xor(sq, 16); sq += __shfl_xor(sq, 32);
                if (fq == 0) *(float*)((char*)ss + (unsigned)(grow * 16 + u.pn * 4 + wc) * 4u) = sq; }
    }
};
struct EpiGU {
    const f32x4* rinfo;
    __device__ __forceinline__ void operator()(const f32x4 (&acc)[2][2][4][2], const Unit& u, int wr, int wc, int fr, int fq) const {
        const unsigned lcol = (unsigned)(wc * 32 + 8 * fq) * 2u;
#pragma unroll
        for (int ai = 0; ai < 2; ++ai)
#pragma unroll
            for (int m = 0; m < 4; ++m) { const int r = ai * 128 + wr * 64 + m * 16 + fr; const int rr = r < u.aux1 ? r : u.aux1 - 1;
                const f32x4 info = ldg16f(rinfo, (unsigned)(u.aux0 + rr) * 16u); const float rs = info.x, wgt = u.aux2 ? info.z : info.y;
                f32x4 h0, h1;
#pragma unroll
                for (int j = 0; j < 4; ++j) { const float g0 = acc[ai][0][m][0][j] * rs, u0 = acc[ai][1][m][0][j] * rs, g1 = acc[ai][0][m][1][j] * rs, u1 = acc[ai][1][m][1][j] * rs;
                    h0[j] = g0 * __builtin_amdgcn_rcpf(1.f + __builtin_amdgcn_exp2f(-g0 * LOG2E)) * u0 * wgt;
                    h1[j] = g1 * __builtin_amdgcn_rcpf(1.f + __builtin_amdgcn_exp2f(-g1 * LOG2E)) * u1 * wgt; }
                stg16(u.O, (unsigned)(r * u.ldc) * 2u + lcol, pack8(h0, h1)); }
    }
};
struct EpiDown {
    const f32x4* rinfo; const bf16_t* h2; float* out; float* ss;
    __device__ __forceinline__ void operator()(const f32x4 (&acc)[2][2][4][2], const Unit& u, int wr, int wc, int fr, int fq) const {
        const int col0 = u.pn * 256 + wc * 32 + 8 * fq;
#pragma unroll
        for (int ai = 0; ai < 2; ++ai)
#pragma unroll
            for (int m = 0; m < 4; ++m) { const int r = ai * 128 + wr * 64 + m * 16 + fr; const bool valid = r < u.aux1; const int rr = valid ? r : u.aux1 - 1;
                const int tok = __builtin_bit_cast(int, ldg16f(rinfo, (unsigned)(u.aux0 + rr) * 16u).w); float sq = 0.f;
#pragma unroll
                for (int bj = 0; bj < 2; ++bj) { const unsigned eoff = (unsigned)(tok * D + col0 + bj * 128);
                    const u32x4 w = ldg16(h2, eoff * 2u);
                    const f32x4 v0 = acc[ai][bj][m][0] + (f32x4){bflo(w.x), bfhi(w.x), bflo(w.y), bfhi(w.y)}, v1 = acc[ai][bj][m][1] + (f32x4){bflo(w.z), bfhi(w.z), bflo(w.w), bfhi(w.w)};
                    sq += sq8(v0, v1);
                    if (valid) { stg16f(out, eoff * 4u, v0); stg16f(out, eoff * 4u + 16u, v1); } }
                sq += __shfl_xor(sq, 16); sq += __shfl_xor(sq, 32);
                if (fq == 0 && valid) *(float*)((char*)ss + (unsigned)(tok * 16 + u.pn * 4 + wc) * 4u) = sq; }
    }
};

__device__ __forceinline__ void sb_attn_unit(const bf16_t* __restrict__ QKU, const bf16_t* __restrict__ VT, bf16_t* __restrict__ MIX, int u, int lane) {
    const int b = u >> 11, h = (u >> 8) & 7, qg = u & 255, r = lane & 31, hi = lane >> 5;
    const size_t tok0 = (size_t)b * SEQ;
    const bf16_t* qp = QKU + (tok0 + qg * 32 + r) * QKU_LD + 512 + h * 64 + 8 * hi;
    bf16x8 qf[4];
#pragma unroll
    for (int ks = 0; ks < 4; ++ks) qf[ks] = *(const bf16x8*)(qp + 16 * ks);
    f32x16 o0, o1;
#pragma unroll
    for (int i = 0; i < 16; ++i) { o0[i] = 0.f; o1[i] = 0.f; }
    float carry = 1.f;
    const int kperm = (r & 0x13) | ((r & 4) << 1) | ((r & 8) >> 1);
    const bf16_t* kbase = QKU + (tok0 + kperm) * QKU_LD + 1024 + h * 64 + 8 * hi;
    const bf16_t* vbase = VT + (size_t)(h * 64 + r) * NTOK + tok0 + 8 * hi;
    const int t = qg * 32 + r;
    for (int kt = qg; kt >= 0; --kt) {
        const bf16_t* kp = kbase + (size_t)kt * 32 * QKU_LD; const bf16_t* vp = vbase + kt * 32;
        bf16x8 kf[4];
#pragma unroll
        for (int ks = 0; ks < 4; ++ks) kf[ks] = *(const bf16x8*)(kp + 16 * ks);
        const bf16x8 v00 = *(const bf16x8*)(vp), v01 = *(const bf16x8*)(vp + 16), v10 = *(const bf16x8*)(vp + (size_t)32 * NTOK), v11 = *(const bf16x8*)(vp + (size_t)32 * NTOK + 16);
        f32x16 s;
#pragma unroll
        for (int i = 0; i < 16; ++i) s[i] = 0.f;
#pragma unroll
        for (int ks = 0; ks < 4; ++ks) s = MFMA32(kf[ks], qf[ks], s);
        float e[16], p[16];
        const bool diag = (kt == qg);
#pragma unroll
        for (int i = 0; i < 16; ++i) { const int key = kt * 32 + ((i & 8) << 1) + 8 * hi + (i & 7);
            float ee = __builtin_amdgcn_exp2f(fminf(s[i], 100.f)); float rr = __builtin_amdgcn_rcpf(1.f + ee);
            if (diag && key >= t) { ee = 0.f; rr = 1.f; }
            e[i] = ee; p[i] = rr; }
#pragma unroll
        for (int i = 6; i >= 0; --i) { p[i] *= p[i + 1]; p[8 + i] *= p[9 + i]; }
        const float Ta = p[0], Tb = p[8], pTa = __shfl_xor(Ta, 32), pTb = __shfl_xor(Tb, 32);
        const float offb = hi ? carry : carry * pTb;
        const float offa = hi ? carry * Tb * pTb : carry * pTb * Tb * pTa;
        carry = carry * ((Ta * Tb) * (pTa * pTb));
        u32x4 w0, w1;
        w0.x = cvtpk(e[0] * p[0] * offa, e[1] * p[1] * offa); w0.y = cvtpk(e[2] * p[2] * offa, e[3] * p[3] * offa); w0.z = cvtpk(e[4] * p[4] * offa, e[5] * p[5] * offa); w0.w = cvtpk(e[6] * p[6] * offa, e[7] * p[7] * offa);
        w1.x = cvtpk(e[8] * p[8] * offb, e[9] * p[9] * offb); w1.y = cvtpk(e[10] * p[10] * offb, e[11] * p[11] * offb); w1.z = cvtpk(e[12] * p[12] * offb, e[13] * p[13] * offb); w1.w = cvtpk(e[14] * p[14] * offb, e[15] * p[15] * offb);
        const bf16x8 wa = __builtin_bit_cast(bf16x8, w0), wb = __builtin_bit_cast(bf16x8, w1);
        o0 = MFMA32(v00, wa, o0); o0 = MFMA32(v01, wb, o0); o1 = MFMA32(v10, wa, o1); o1 = MFMA32(v11, wb, o1);
        if (__all(carry < 7.8e-31f)) break;
    }
    bf16_t* op = MIX + (tok0 + qg * 32 + r) * D + 512 + h * 64 + 4 * hi;
#pragma unroll
    for (int g = 0; g < 4; ++g) { u32x2 a, c; a.x = cvtpk(o0[4 * g], o0[4 * g + 1]); a.y = cvtpk(o0[4 * g + 2], o0[4 * g + 3]); c.x = cvtpk(o1[4 * g], o1[4 * g + 1]); c.y = cvtpk(o1[4 * g + 2], o1[4 * g + 3]);
        *(u32x2*)(op + 8 * g) = a; *(u32x2*)(op + 32 + 8 * g) = c; }
}
__device__ __forceinline__ void pool_unit(const bf16_t* __restrict__ QKU, const bf16_t* __restrict__ WPT, const float* __restrict__ pscale, bf16_t* __restrict__ MIX, int u, int lane) {
    const int tg = u >> 2, g = u & 3, w = 2 << g, r = lane & 31, hi = lane >> 5;
    const int tok = tg * 32 + r, t = tok & (SEQ - 1);
    const int nwin = (t + 1) < w ? (t + 1) : w; const float inv = 1.f / (float)nwin;
    const bf16_t* up = QKU + (size_t)tok * QKU_LD + g * 128 + 8 * hi;
    bf16x8 pf[8];
#pragma unroll
    for (int ks = 0; ks < 8; ++ks) {
        float sm[8];
#pragma unroll
        for (int j = 0; j < 8; ++j) sm[j] = 0.f;
        u32x4 self = *(const u32x4*)(up + 16 * ks);
        for (int i = 0; i < w; ++i) { if (i < nwin) { const u32x4 x = *(const u32x4*)(up + 16 * ks - (size_t)i * QKU_LD);
            sm[0] += bflo(x.x); sm[1] += bfhi(x.x); sm[2] += bflo(x.y); sm[3] += bfhi(x.y); sm[4] += bflo(x.z); sm[5] += bfhi(x.z); sm[6] += bflo(x.w); sm[7] += bfhi(x.w); } }
        u32x4 o; o.x = cvtpk(sm[0] * inv - bflo(self.x), sm[1] * inv - bfhi(self.x)); o.y = cvtpk(sm[2] * inv - bflo(self.y), sm[3] * inv - bfhi(self.y));
        o.z = cvtpk(sm[4] * inv - bflo(self.z), sm[5] * inv - bfhi(self.z)); o.w = cvtpk(sm[6] * inv - bflo(self.w), sm[7] * inv - bfhi(self.w));
        pf[ks] = __builtin_bit_cast(bf16x8, o);
    }
    const bf16_t* wp = WPT + (size_t)g * 128 * 128 + (size_t)r * 128 + 8 * hi;
    bf16_t* op = MIX + (size_t)tok * D + g * 128 + 4 * hi;
#pragma unroll
    for (int mb = 0; mb < 4; ++mb) {
        f32x16 acc;
#pragma unroll
        for (int i = 0; i < 16; ++i) acc[i] = 0.f;
#pragma unroll
        for (int ks = 0; ks < 8; ++ks) { const bf16x8 a = *(const bf16x8*)(wp + (size_t)mb * 32 * 128 + 16 * ks); acc = MFMA32(a, pf[ks], acc); }
#pragma unroll
        for (int q = 0; q < 4; ++q) { const f32x4 sc = *(const f32x4*)(pscale + g * 128 + mb * 32 + 8 * q + 4 * hi);
            u32x2 o; o.x = cvtpk(acc[4 * q] * sc.x, acc[4 * q + 1] * sc.y); o.y = cvtpk(acc[4 * q + 2] * sc.z, acc[4 * q + 3] * sc.w);
            *(u32x2*)(op + mb * 32 + 8 * q) = o; }
    }
}

__device__ __forceinline__ void cross_unit(const bf16_t* __restrict__ QM, const bf16_t* __restrict__ KMEM, const bf16_t* __restrict__ VMT, bf16_t* __restrict__ OC, int u, int lane) {
    const int rg = u >> 2, hd = u & 3, r = lane & 31, hi = lane >> 5, tok0 = rg * 32, b = tok0 >> 13;
    const int kperm = (r & 0x13) | ((r & 4) << 1) | ((r & 8) >> 1);
    const bf16_t* qp = QM + (size_t)(tok0 + r) * D + hd * 256 + 8 * hi;
    const bf16_t* kp = KMEM + (size_t)(b * 256 + kperm) * D + hd * 256 + 8 * hi;
    f32x16 s[8];
#pragma unroll
    for (int kb = 0; kb < 8; ++kb)
#pragma unroll
        for (int i = 0; i < 16; ++i) s[kb][i] = 0.f;
#pragma unroll 2
    for (int ks = 0; ks < 16; ++ks) { const bf16x8 qf = *(const bf16x8*)(qp + 16 * ks);
#pragma unroll
        for (int kb = 0; kb < 8; ++kb) { const bf16x8 kf = *(const bf16x8*)(kp + (size_t)kb * 32 * D + 16 * ks); s[kb] = MFMA32(kf, qf, s[kb]); } }
    float mx = -3.0e38f;
#pragma unroll
    for (int kb = 0; kb < 8; ++kb)
#pragma unroll
        for (int i = 0; i < 16; ++i) mx = fmaxf(mx, s[kb][i]);
    mx = fmaxf(mx, __shfl_xor(mx, 32));
    float sum = 0.f; bf16x8 pf[16];
#pragma unroll
    for (int kb = 0; kb < 8; ++kb) {
        float e[16];
#pragma unroll
        for (int i = 0; i < 16; ++i) { e[i] = __builtin_amdgcn_exp2f(s[kb][i] - mx); sum += e[i]; }
        u32x4 w0, w1; w0.x = cvtpk(e[0], e[1]); w0.y = cvtpk(e[2], e[3]); w0.z = cvtpk(e[4], e[5]); w0.w = cvtpk(e[6], e[7]);
        w1.x = cvtpk(e[8], e[9]); w1.y = cvtpk(e[10], e[11]); w1.z = cvtpk(e[12], e[13]); w1.w = cvtpk(e[14], e[15]);
        pf[2 * kb] = __builtin_bit_cast(bf16x8, w0); pf[2 * kb + 1] = __builtin_bit_cast(bf16x8, w1);
    }
    sum += __shfl_xor(sum, 32);
    const float inv = 1.f / sum;
    const bf16_t* vp = VMT + (size_t)(hd * 256 + r) * 1024 + b * 256 + 8 * hi;
    bf16_t* op = OC + (size_t)(tok0 + r) * D + hd * 256 + 4 * hi;
#pragma unroll 1
    for (int dh = 0; dh < 2; ++dh) {
        f32x16 o[4];
#pragma unroll
        for (int db = 0; db < 4; ++db)
#pragma unroll
            for (int i = 0; i < 16; ++i) o[db][i] = 0.f;
#pragma unroll
        for (int ks = 0; ks < 16; ++ks)
#pragma unroll
            for (int db = 0; db < 4; ++db) { const bf16x8 vf = *(const bf16x8*)(vp + (size_t)((dh * 4 + db) * 32) * 1024 + 16 * ks); o[db] = MFMA32(vf, pf[ks], o[db]); }
#pragma unroll
        for (int db = 0; db < 4; ++db)
#pragma unroll
            for (int q = 0; q < 4; ++q) { u32x2 w; w.x = cvtpk(o[db][4 * q] * inv, o[db][4 * q + 1] * inv); w.y = cvtpk(o[db][4 * q + 2] * inv, o[db][4 * q + 3] * inv);
                *(u32x2*)(op + (dh * 4 + db) * 32 + 8 * q) = w; }
    }
}

__device__ __forceinline__ void router_unit(const bf16_t* __restrict__ H2, const bf16_t* __restrict__ WR, const float* __restrict__ SS2, f32x4* __restrict__ RINFO, unsigned* ctl, int rg, int lane) {
    const int r = lane & 31, hi = lane >> 5, tok = rg * 32 + r;
    const bf16_t* hp = H2 + (size_t)tok * D + 8 * hi;
    const bf16_t* wh = WR + (size_t)r * D + 8 * hi; const bf16_t* wl = wh + 32 * D;
    f32x16 acc;
#pragma unroll
    for (int i = 0; i < 16; ++i) acc[i] = 0.f;
#pragma unroll 4
    for (int ks = 0; ks < 64; ++ks) { const bf16x8 x = *(const bf16x8*)(hp + 16 * ks), a = *(const bf16x8*)(wh + 16 * ks), c = *(const bf16x8*)(wl + 16 * ks);
        acc = MFMA32(a, x, acc); acc = MFMA32(c, x, acc); }
    float xo[8];
#pragma unroll
    for (int i = 0; i < 8; ++i) xo[i] = __shfl_xor(acc[4 + i], 32);
    const f32x4* sp = (const f32x4*)(SS2 + (size_t)tok * 16); const f32x4 a = sp[0], bq = sp[1], c = sp[2], d = sp[3];
    const float tss = ((a.x + a.y) + (a.z + a.w)) + ((bq.x + bq.y) + (bq.z + bq.w)) + ((c.x + c.y) + (c.z + c.w)) + ((d.x + d.y) + (d.z + d.w));
    const float rs = 1.0f / sqrtf(tss * (1.f / D) + RMS_EPS);
    float gl[4] = {acc[0] * rs, acc[1] * rs, acc[2] * rs, acc[3] * rs};
    int gi = 0; float gm = gl[0];
#pragma unroll
    for (int j = 1; j < 4; ++j) if (gl[j] > gm) { gm = gl[j]; gi = j; }
    float gsum = 0.f;
#pragma unroll
    for (int j = 0; j < 4; ++j) gsum += __builtin_amdgcn_exp2f((gl[j] - gm) * LOG2E);
    const float ggate = 1.f / gsum;
    float el[4];
#pragma unroll
    for (int j = 0; j < 4; ++j) { const float e0 = acc[4 + j], e1 = xo[j], e2 = acc[8 + j], e3 = xo[4 + j]; el[j] = (gi == 0 ? e0 : gi == 1 ? e1 : gi == 2 ? e2 : e3) * rs; }
    int i1 = 0; float m1 = el[0];
#pragma unroll
    for (int j = 1; j < 4; ++j) if (el[j] > m1) { m1 = el[j]; i1 = j; }
    int i2 = -1; float m2 = -3.0e38f;
#pragma unroll
    for (int j = 0; j < 4; ++j) if (j != i1 && el[j] > m2) { m2 = el[j]; i2 = j; }
    const float ex = __builtin_amdgcn_exp2f((m2 - m1) * LOG2E); const float w1 = 1.f / (1.f + ex), w2 = ex * w1;
    const int lo = i1 < i2 ? i1 : i2, hh = i1 < i2 ? i2 : i1;
    const float wlo = ggate * (i1 < i2 ? w1 : w2), whi = ggate * (i1 < i2 ? w2 : w1);
    const int pair = lo == 0 ? hh - 1 : (lo == 1 ? hh + 1 : 5);
    const int combo = gi * 6 + pair;
    const bool owner = (hi == 0);
    int pos = 0;
#pragma unroll 1
    for (int cb = 0; cb < NCOMBO; ++cb) {
        const unsigned long long mask = __ballot(owner && combo == cb);
        if (mask) { const int n = __popcll(mask); unsigned base = 0;
            if (lane == 0) base = __hip_atomic_fetch_add(ctl + CW_CNT + 64 * cb, (unsigned)n, RLX_AGENT);
            base = __builtin_amdgcn_readfirstlane(base);
            if (owner && combo == cb) pos = (int)base + __popcll(mask & ((1ull << lane) - 1ull)); }
    }
    if (owner) RINFO[(size_t)combo * NTOK + pos] = (f32x4){rs, wlo, whi, __builtin_bit_cast(float, tok)};
}

struct Args { const float* in[20]; float* out; unsigned char* ws; int ph_lo, ph_hi; };
constexpr int N_PHASES = 11;

__global__ void __launch_bounds__(NWAVES * 64, 2) fwd(Args args) {
    extern __shared__ __attribute__((aligned(16))) unsigned char lds_raw[];
    Frame F;
    F.lds = (LAS unsigned char*)lds_raw;
    F.MISC = (volatile LAS unsigned*)(F.lds + LDSCTL_OFF);
    F.tid = threadIdx.x; F.lane = F.tid & 63; F.wave = __builtin_amdgcn_readfirstlane(F.tid >> 6);
    F.G = gridDim.x; { const int bx = blockIdx.x; F.vcu = (F.G % 8 == 0) ? (bx % 8) * (F.G / 8) + bx / 8 : bx; }
    unsigned char* ws = args.ws; F.ws = ws;
    F.ctl = (unsigned*)(ws + WS_CTL);
    for (int u = F.tid; u < (LDS_BYTES - LDSCTL_OFF) / 4; u += NWAVES * 64) ((LAS unsigned*)(F.lds + LDSCTL_OFF))[u] = 0u;
    __syncthreads();
    const int lo = args.ph_lo, hi = args.ph_hi;
    const bool multi = (hi - lo) > 1;
    XcdBarrier bar; bar.bar = F.ctl + CW_BAR; bar.x = 0; bar.st = nullptr;
    if (multi) bar = xcd_barrier_post(F.ctl + CW_BAR, F.MISC + MW_BAR);
#ifndef PHASE_MASK
#define PHASE_MASK 0x7ff
#endif
#define IN(k) (((PHASE_MASK >> (k)) & 1) && lo <= (k) && (k) < hi)
#define SEAM(k) do { if (IN(k) && IN((k) + 1)) xcd_barrier(bar); } while (0)

    bf16_t* const XN = (bf16_t*)(ws + WS_RA);  bf16_t* const MIX = XN; bf16_t* const QM = XN; bf16_t* const H2 = XN;
    bf16_t* const QKU = (bf16_t*)(ws + WS_RB); bf16_t* const VT = (bf16_t*)(ws + WS_VT);
    bf16_t* const H1 = (bf16_t*)(ws + WS_RB);  bf16_t* const OC = (bf16_t*)(ws + WS_OC); bf16_t* const HH = (bf16_t*)(ws + WS_RB);
    const int gw = F.vcu * NWAVES + F.wave, NGW = F.G * NWAVES;

    if (IN(0)) { p0_prologue(F, args.in); }
    SEAM(0);
    if (IN(1)) {
        SchedP1 S{(const char*)XN, (const char*)(ws + WS_WIN), (char*)QKU, (char*)VT, F.G, (int)blockIdx.x};
        EpiStore E{nullptr, 1.f};
        pg8::gemm_phase<EpiStore, SchedP1, false, true>(F.lds, D, D, D, S, E);
    }
    SEAM(1);
    if (IN(2)) {
        SchedMemKV S{(const char*)(ws + WS_MEMN), (const char*)(ws + WS_WKV), (char*)(ws + WS_KMEM), (char*)(ws + WS_VMT), F.G, (int)blockIdx.x};
        EpiStore E{nullptr, 1.f};
        pg8::gemm_phase<EpiStore, SchedMemKV, false, true>(F.lds, D, D, D, S, E);
        constexpr int NATT = NB * 8 * 256, NPOOL = (NTOK / 32) * 4;
        for (;;) {
            unsigned u = 0; if (F.lane == 0) u = __hip_atomic_fetch_add(F.ctl + CW_QUEUE, 1u, RLX_AGENT);
            u = __builtin_amdgcn_readfirstlane(u);
            if (u >= (unsigned)(NATT + NPOOL)) break;
            if (u < (unsigned)NATT) sb_attn_unit(QKU, VT, MIX, (int)u, F.lane);
            else pool_unit(QKU, (const bf16_t*)(ws + WS_WP), args.in[I_POOL_SCALE], MIX, (int)u - NATT, F.lane);
        }
    }
    SEAM(2);
    if (IN(3)) {
        SchedStd S{(const char*)MIX, (const char*)(ws + WS_WOUT), nullptr, F.G, (int)blockIdx.x};
        EpiRes<true> E{(const void*)args.in[I_X], H1, (float*)(ws + WS_SS1)};
        pg8::gemm_phase<EpiRes<true>, SchedStd, false, true>(F.lds, D, D, D, S, E);
    }
    SEAM(3);
    if (IN(4)) {
        SchedStd S{(const char*)H1, (const char*)(ws + WS_WQ), QM, F.G, (int)blockIdx.x};
        EpiStore E{(const float*)(ws + WS_SS1), QSCALE_MEM};
        pg8::gemm_phase<EpiStore, SchedStd, false, true>(F.lds, D, D, D, S, E);
    }
    SEAM(4);
    if (IN(5)) {
        for (int u = gw; u < (NTOK / 32) * 4; u += NGW) cross_unit(QM, (const bf16_t*)(ws + WS_KMEM), (const bf16_t*)(ws + WS_VMT), OC, u, F.lane);
    }
    SEAM(5);
    if (IN(6)) {
        SchedStd S{(const char*)OC, (const char*)(ws + WS_WO), nullptr, F.G, (int)blockIdx.x};
        EpiRes<false> E{(const void*)H1, H2, (float*)(ws + WS_SS2)};
        pg8::gemm_phase<EpiRes<false>, SchedStd, false, true>(F.lds, D, D, D, S, E);
    }
    SEAM(6);
    if (IN(7)) {
        for (int rg = gw; rg < NTOK / 32; rg += NGW) router_unit(H2, (const bf16_t*)(ws + WS_WR), (const float*)(ws + WS_SS2), (f32x4*)(ws + WS_RINFO), F.ctl, rg, F.lane);
    }
    SEAM(7);
    if (IN(8) || IN(9)) {
        __syncthreads();
        if (F.tid < NCOMBO) F.MISC[MW_CNT + F.tid] = __hip_atomic_load(F.ctl + CW_CNT + 64 * F.tid, RLX_AGENT);
        __syncthreads();
        if (F.tid == 0) { unsigned acc = 0; for (int k = 0; k < NCOMBO; ++k) { F.MISC[MW_TP + k] = acc; acc += (F.MISC[MW_CNT + k] + 255u) >> 8; } F.MISC[MW_TP + NCOMBO] = acc; }
        __syncthreads();
    }
    if (IN(8)) {
        SchedP8 S{F.MISC, (const char*)H2, (const char*)(ws + WS_GU), (char*)HH, (const f32x4*)(ws + WS_RINFO), F.G, F.vcu};
        EpiGU E{(const f32x4*)(ws + WS_RINFO)};
        pg8::gemm_phase<EpiGU, SchedP8, true, true>(F.lds, D, D, D, S, E);
    }
    SEAM(8);
    if (IN(9)) {
        SchedP9 S{F.MISC, (const char*)HH, (const char*)(ws + WS_WD), F.G, F.vcu};
        EpiDown E{(const f32x4*)(ws + WS_RINFO), H2, args.out, (float*)(ws + WS_SS3)};
        pg8::gemm_phase<EpiDown, SchedP9, false, true>(F.lds, D, 512, 512, S, E);
    }
    SEAM(9);
    if (IN(10)) {
        const float* ss3 = (const float*)(ws + WS_SS3); const f32x4* gf = (const f32x4*)args.in[I_NORM_FINAL] + F.lane;
        for (int m = gw; m < NTOK; m += NGW) {
            const f32x4* sp = (const f32x4*)(ss3 + (size_t)m * 16); const f32x4 a = sp[0], b = sp[1], c = sp[2], d = sp[3];
            const float t = ((a.x + a.y) + (a.z + a.w)) + ((b.x + b.y) + (b.z + b.w)) + ((c.x + c.y) + (c.z + c.w)) + ((d.x + d.y) + (d.z + d.w));
            const float rs = 1.0f / sqrtf(t * (1.f / D) + RMS_EPS);
            f32x4* o = (f32x4*)(args.out + (size_t)m * D) + F.lane;
#pragma unroll
            for (int j = 0; j < 4; ++j) { const f32x4 g = gf[64 * j]; f32x4 v = o[64 * j]; v.x *= rs * g.x; v.y *= rs * g.y; v.z *= rs * g.z; v.w *= rs * g.w; o[64 * j] = v; }
        }
    }
#undef IN
#undef SEAM
}

extern "C" void kernel_launch(void* const* d_in, const int* in_sizes, int n_in, void* d_out, int out_size, void* d_ws, size_t ws_size, hipStream_t stream) {
    static int grid = 0;
    if (grid == 0) {
        if (n_in != 20 || in_sizes[0] != NTOK * D || out_size != NTOK * D || ws_size < WS_END) { fprintf(stderr, "kernel_launch: unexpected shapes (n_in %d, in0 %d, out %d, ws %zu); nothing launched\n", n_in, n_in > 0 ? in_sizes[0] : -1, out_size, ws_size); grid = -1; return; }
        int dev = 0, cus = 0, per_cu = 0;
        if (hipGetDevice(&dev) != hipSuccess || hipDeviceGetAttribute(&cus, hipDeviceAttributeMultiprocessorCount, dev) != hipSuccess) { grid = -1; return; }
        if (hipFuncSetAttribute((const void*)fwd, hipFuncAttributeMaxDynamicSharedMemorySize, LDS_BYTES) != hipSuccess) { fprintf(stderr, "kernel_launch: hipFuncSetAttribute failed\n"); grid = -1; return; }
        if (hipOccupancyMaxActiveBlocksPerMultiprocessor(&per_cu, (const void*)fwd, NWAVES * 64, LDS_BYTES) != hipSuccess || per_cu < 1) { fprintf(stderr, "kernel_launch: occupancy query reports %d blocks per CU\n", per_cu); }
        (void)hipGetLastError();
        grid = cus;
    }
    if (grid < 0) return;
    if (hipMemsetAsync((char*)d_ws + WS_CTL, 0, CTL_ZERO_BYTES, stream) != hipSuccess) return;
    Args a{};
    for (int i = 0; i < 20; ++i) a.in[i] = (const float*)d_in[i];
    a.out = (float*)d_out; a.ws = (unsigned char*)d_ws;
    if (MK_N_LAUNCHES == 1) { a.ph_lo = 0; a.ph_hi = N_PHASES; hipLaunchKernelGGL(fwd, dim3(grid), dim3(NWAVES * 64), LDS_BYTES, stream, a); }
    else { for (int p = 0; p < N_PHASES; ++p) { a.ph_lo = p; a.ph_hi = p + 1; hipLaunchKernelGGL(fwd, dim3(grid), dim3(NWAVES * 64), LDS_BYTES, stream, a); } }
}
```

```cpp
#include <hip/hip_runtime.h>
#include <cstdio>
#include <cstdint>

#ifndef MK_N_LAUNCHES
#define MK_N_LAUNCHES 1
#endif

#define LAS __attribute__((address_space(3)))
#define GAS __attribute__((address_space(1)))
typedef unsigned short bf16_t;
typedef short bf16x8 __attribute__((ext_vector_type(8)));
typedef float f32x2 __attribute__((ext_vector_type(2)));
typedef float f32x4 __attribute__((ext_vector_type(4)));
typedef float f32x16 __attribute__((ext_vector_type(16)));
typedef unsigned u32x2 __attribute__((ext_vector_type(2)));
typedef unsigned u32x4 __attribute__((ext_vector_type(4)));
typedef __bf16 bf16x2_t __attribute__((ext_vector_type(2)));
typedef GAS unsigned gu32;

constexpr int NTOK = 32768, SEQ = 8192, NB = 4, D = 1024;
constexpr int INW = 2048;
constexpr int QKU_LD = 1536;
constexpr int MEMROWS = 1024;
constexpr int NCOMBO = 24;
constexpr float RMS_EPS = 1e-6f;
constexpr float LOG2E = 1.4426950408889634f;
constexpr float QSCALE_SB = 0.125f * LOG2E;
constexpr float QSCALE_MEM = 0.0625f * LOG2E;

constexpr size_t MiB = 1u << 20;
constexpr size_t WS_CTL = 0, CTL_ZERO_BYTES = 1 * MiB;
constexpr size_t WS_WIN = 2 * MiB;
constexpr size_t WS_WOUT = 6 * MiB;
constexpr size_t WS_WQ = 8 * MiB;
constexpr size_t WS_WKV = 10 * MiB;
constexpr size_t WS_WO = 14 * MiB;
constexpr size_t WS_GU = 16 * MiB;
constexpr size_t WS_WD = 48 * MiB;
constexpr size_t WS_WP = 64 * MiB;
constexpr size_t WS_WR = 64 * MiB + 256 * 1024;
constexpr size_t WS_MEMN = 65 * MiB;
constexpr size_t WS_KMEM = 67 * MiB;
constexpr size_t WS_VMT = 69 * MiB;
constexpr size_t WS_SS1 = 72 * MiB;
constexpr size_t WS_SS2 = 74 * MiB;
constexpr size_t WS_SS3 = 76 * MiB;
constexpr size_t WS_RINFO = 80 * MiB;
constexpr size_t WS_RA = 96 * MiB;
constexpr size_t WS_RB = 160 * MiB;
constexpr size_t WS_END = 288 * MiB;
constexpr size_t WS_VT = WS_RB + 96 * MiB;
constexpr size_t WS_OC = WS_RB + 64 * MiB;
constexpr int CW_TMO = 0;
constexpr int CW_QUEUE = 1024;
constexpr int CW_CNT = 2048;
constexpr int CW_BAR = 4096;

constexpr int RING_BYTES = 131072;
constexpr int LDSCTL_OFF = 139264;
constexpr int LDS_BYTES = 147456;
constexpr int MW_BAR = 8, MW_CUR = 12, MW_CNT = 16, MW_TP = 40;
#ifndef P2_SLOTS_GEMM
#define P2_SLOTS_GEMM 27
#define P2_SLOTS_OTHER 51
#endif

constexpr int NWAVES = 8;

#define LDS_WAIT() asm volatile("s_waitcnt lgkmcnt(0)" ::: "memory")
#define VM_WAIT() asm volatile("s_waitcnt vmcnt(0)" ::: "memory")
#define RLX_AGENT __ATOMIC_RELAXED, __HIP_MEMORY_SCOPE_AGENT

__device__ __forceinline__ unsigned f2bf(float f) { unsigned u = __builtin_bit_cast(unsigned, f); return (u + 0x7fffu + ((u >> 16) & 1u)) >> 16; }
__device__ __forceinline__ unsigned pk2(float lo, float hi) { return f2bf(lo) | (f2bf(hi) << 16); }
__device__ __forceinline__ unsigned cvtpk(float lo, float hi) { f32x2 v = {lo, hi}; bf16x2_t b = __builtin_convertvector(v, bf16x2_t); return __builtin_bit_cast(unsigned, b); }
__device__ __forceinline__ float bflo(unsigned w) { return __builtin_bit_cast(float, w << 16); }
__device__ __forceinline__ float bfhi(unsigned w) { return __builtin_bit_cast(float, w & 0xffff0000u); }
__device__ __forceinline__ float wave_sum(float v) {
#pragma unroll
    for (int o = 1; o < 64; o <<= 1) v += __shfl_xor(v, o);
    return v;
}
#define MFMA32(a, b, c) __builtin_amdgcn_mfma_f32_32x32x16_bf16((a), (b), (c), 0, 0, 0)

namespace pg8 {
constexpr int BM = 256, BK = 64, HALF = 128, HTB = HALF * BK * 2, STAGE_BYTES = 8 * HTB, NXCD = 8, WGM = 8;
__host__ __device__ __forceinline__ int lds_byte(int r, int c) { const int st = (r >> 4) * 2 + (c >> 5), rr = r & 15, cc = c & 31, ob = rr * 64 + cc * 2; return st * 1024 + (ob ^ (((ob >> 9) & 1) << 5)); }
__host__ __device__ __forceinline__ void stage_rc(int b, int& R, int& C) { const int st = b / 1024, sb = b % 1024, swz = sb ^ (((sb >> 9) & 1) << 5); R = (st >> 1) * 16 + swz / 64; C = (st & 1) * 32 + (swz % 64) / 2; }
__host__ __device__ __forceinline__ int perm32(int rho) { const int n = rho >> 4, i = rho & 15; return 8 * (i >> 2) + 4 * n + (i & 3); }

struct Unit { const char* A; const char* B; char* O; int ldc; float scale; int pm, pn, flags, aux0, aux1, aux2; };

__device__ __forceinline__ void map_std(int nM, int nN, int L, int& pm, int& pn) {
    const int nwg = nM * nN; int wgid = L; { const int q = nwg / NXCD, r = nwg % NXCD, xcd = wgid % NXCD, off = wgid / NXCD; wgid = (xcd < r ? xcd * (q + 1) : r * (q + 1) + (xcd - r) * q) + off; }
    const int nig = WGM * nN, gid = wgid / nig, fm = gid * WGM, gsz = (nM - fm) < WGM ? (nM - fm) : WGM;
    pm = fm + ((wgid % nig) % gsz); pn = (wgid % nig) / gsz;
}

template <class Epi, class Sched, bool GATHER, bool ALIGN_EPI>
__device__ __forceinline__ void gemm_phase(LAS unsigned char* lds, const int lda, const int ldb, const int K, const Sched& S, const Epi& E) {
    const int tid = threadIdx.x, wid = __builtin_amdgcn_readfirstlane(tid >> 6), lane = tid & 63, wr = wid >> 2, wc = wid & 3, fr = lane & 15, fq = lane >> 4;
    const int nt = K / BK;
    int R0, C0; stage_rc(tid * 16, R0, C0);
    const int R1 = R0 + 64;
    const int Rb0 = (R0 & ~31) + perm32(R0 & 31), Rb1 = (R1 & ~31) + perm32(R1 & 31);
    unsigned voffB[2]; voffB[0] = (unsigned)(Rb0 * ldb + C0) * 2u; voffB[1] = (unsigned)(Rb1 * ldb + C0) * 2u;
    unsigned cvA[2][2];
    const size_t kstep = (size_t)(BK * 2);
    const size_t hstepB = (size_t)HALF * ldb * 2;
    const unsigned ldsw = (unsigned)wid * 1024u;
    const int aoff = lds_byte(wr * 64 + fr, fq * 8), boff = lds_byte(wc * 32 + fr, fq * 8);
#define PG8_SA(b, h) (((b) * 2 + (h)) * HTB)
#define PG8_SB(b, h) ((4 + (b) * 2 + (h)) * HTB)
#define PG8_STAGE(bufoff, gbase, voff) do { _Pragma("unroll") for (int _i = 0; _i < 2; ++_i) \
        __builtin_amdgcn_global_load_lds((const unsigned*)((const char*)(gbase) + (voff)[_i]), (LAS unsigned*)(lds + (bufoff) + ldsw + _i * 8192), 16, 0, 0); } while (0)
#define PG8_LDA(dst, b, h) do { _Pragma("unroll") for (int m = 0; m < 4; ++m) _Pragma("unroll") for (int k = 0; k < 2; ++k) dst[m][k] = *(const LAS bf16x8*)(lds + PG8_SA(b, h) + aoff + m * 2048 + k * 1024); } while (0)
#define PG8_LDB(dst, b, h) do { _Pragma("unroll") for (int n = 0; n < 2; ++n) _Pragma("unroll") for (int k = 0; k < 2; ++k) dst[n][k] = *(const LAS bf16x8*)(lds + PG8_SB(b, h) + boff + n * 2048 + k * 1024); } while (0)
#define PG8_MMA(ai, bj, At, Bt) do { __builtin_amdgcn_s_setprio(1); _Pragma("unroll") for (int m = 0; m < 4; ++m) _Pragma("unroll") for (int n = 0; n < 2; ++n) _Pragma("unroll") for (int k = 0; k < 2; ++k) \
        acc[ai][bj][m][n] = __builtin_amdgcn_mfma_f32_16x16x32_bf16(Bt[n][k], At[m][k], acc[ai][bj][m][n], 0, 0, 0); __builtin_amdgcn_s_setprio(0); } while (0)
#define PG8_WAIT_V(n) asm volatile("s_waitcnt vmcnt(" #n ")" ::: "memory")
#define PG8_WAIT_L(n) asm volatile("s_waitcnt lgkmcnt(" #n ")" ::: "memory")
#define PG8_BAR __builtin_amdgcn_s_barrier()
#define PG8_SCHED __builtin_amdgcn_sched_barrier(0)
#define PG8_TABLD(u, buf) do { if (wid < 4) { __builtin_amdgcn_global_load_lds(S.tokptr(u, wid * 64 + lane), (LAS unsigned*)(tokTab + (buf) * 256 + wid * 64), 4, 0, 0); } } while (0)
#define PG8_ROWOFF_G(dst, buf) do { const LAS int* _t = tokTab + (buf) * 256; \
        dst[0][0] = (unsigned)(_t[R0] * lda + C0) * 2u; dst[0][1] = (unsigned)(_t[R1] * lda + C0) * 2u; dst[1][0] = (unsigned)(_t[HALF + R0] * lda + C0) * 2u; dst[1][1] = (unsigned)(_t[HALF + R1] * lda + C0) * 2u; } while (0)
    LAS int* const tokTab = (LAS int*)(lds + 139264 + 1024);
    Unit cur, nxt; int ui = 0;
    if (!S.next(0, cur)) return;
    f32x4 acc[2][2][4][2];
#pragma unroll
    for (int a = 0; a < 2; ++a)
#pragma unroll
        for (int b = 0; b < 2; ++b)
#pragma unroll
            for (int m = 0; m < 4; ++m)
#pragma unroll
                for (int n = 0; n < 2; ++n) acc[a][b][m][n] = (f32x4){0.f, 0.f, 0.f, 0.f};
    bf16x8 At[4][2], B0[2][2], B1[2][2];
    if constexpr (GATHER) { PG8_TABLD(cur, 0); PG8_WAIT_V(0); __syncthreads(); PG8_ROWOFF_G(cvA, 0); }
    else { cvA[0][0] = (unsigned)(R0 * lda + C0) * 2u; cvA[0][1] = (unsigned)(R1 * lda + C0) * 2u; cvA[1][0] = (unsigned)((HALF + R0) * lda + C0) * 2u; cvA[1][1] = (unsigned)((HALF + R1) * lda + C0) * 2u; }
    const char* cA = cur.A; const char* cB = cur.B;
    PG8_STAGE(PG8_SB(0, 0), cB, voffB); PG8_STAGE(PG8_SB(0, 1), cB + hstepB, voffB); PG8_STAGE(PG8_SA(0, 0), cA, cvA[0]); PG8_STAGE(PG8_SA(0, 1), cA, cvA[1]);
    if (wr == 1) PG8_BAR;
    PG8_WAIT_V(2); PG8_BAR;
    PG8_STAGE(PG8_SB(1, 0), cB + kstep, voffB); PG8_STAGE(PG8_SA(1, 0), cA + kstep, cvA[0]); PG8_STAGE(PG8_SB(1, 1), cB + hstepB + kstep, voffB);
    PG8_WAIT_V(6); PG8_BAR;
    for (;;) {
        const bool has_next = S.next(ui + 1, nxt);
        const char* nA = has_next ? nxt.A : cA; const char* nB = has_next ? nxt.B : cB;
        if constexpr (GATHER) { if (has_next) PG8_TABLD(nxt, (ui + 1) & 1); }
        for (int t = 0; t < nt; t += 2) {
            const bool last = (t == nt - 2);
            const char* a1 = cA + (size_t)(t + 1) * kstep;
            const char* a2 = last ? nA : cA + (size_t)(t + 2) * kstep; const char* b2 = last ? nB : cB + (size_t)(t + 2) * kstep;
            const char* a3 = a2 + kstep; const char* b3 = b2 + kstep;
            unsigned o2[2][2];
            o2[0][0] = cvA[0][0]; o2[0][1] = cvA[0][1]; o2[1][0] = cvA[1][0]; o2[1][1] = cvA[1][1];
            if constexpr (GATHER) { if (last && has_next) { PG8_ROWOFF_G(o2, (ui + 1) & 1); } }
            PG8_LDB(B0, 0, 0); PG8_LDB(B1, 0, 1); PG8_SCHED; PG8_LDA(At, 0, 0); PG8_STAGE(PG8_SA(1, 1), a1, cvA[1]);
            PG8_WAIT_V(8); PG8_WAIT_L(0); PG8_BAR; PG8_MMA(0, 0, At, B0); PG8_MMA(0, 1, At, B1); PG8_BAR; PG8_SCHED;
            PG8_LDA(At, 0, 1); PG8_STAGE(PG8_SB(0, 0), b2, voffB); PG8_STAGE(PG8_SB(0, 1), b2 + hstepB, voffB); PG8_STAGE(PG8_SA(0, 0), a2, o2[0]);
            PG8_WAIT_V(8); PG8_WAIT_L(0); PG8_BAR; PG8_MMA(1, 0, At, B0); PG8_MMA(1, 1, At, B1); PG8_BAR; PG8_SCHED;
            PG8_LDB(B0, 1, 0); PG8_LDB(B1, 1, 1); PG8_SCHED; PG8_LDA(At, 1, 0); PG8_STAGE(PG8_SA(0, 1), a2, o2[1]);
            PG8_WAIT_V(8); PG8_WAIT_L(0); PG8_BAR; PG8_MMA(0, 0, At, B0); PG8_MMA(0, 1, At, B1); PG8_BAR; PG8_SCHED;
            PG8_LDA(At, 1, 1); PG8_STAGE(PG8_SB(1, 0), b3, voffB); PG8_STAGE(PG8_SB(1, 1), b3 + hstepB, voffB); PG8_STAGE(PG8_SA(1, 0), a3, o2[0]);
            PG8_WAIT_V(8); PG8_WAIT_L(0); PG8_BAR; PG8_MMA(1, 0, At, B0); PG8_MMA(1, 1, At, B1); PG8_BAR; PG8_SCHED;
        }
        if constexpr (ALIGN_EPI) { if (wr == 0) PG8_BAR; }
        if (cur.flags & 2) E(acc, cur, wr, wc, fr, fq);
        if (!has_next) break;
        if (nxt.flags & 1) {
#pragma unroll
            for (int a = 0; a < 2; ++a)
#pragma unroll
                for (int b = 0; b < 2; ++b)
#pragma unroll
                    for (int m = 0; m < 4; ++m)
#pragma unroll
                        for (int n = 0; n < 2; ++n) acc[a][b][m][n] = (f32x4){0.f, 0.f, 0.f, 0.f};
        }
        cur = nxt; cA = nA; cB = nB; ++ui;
        if constexpr (GATHER) { PG8_ROWOFF_G(cvA, ui & 1); }
        if constexpr (ALIGN_EPI) { if (wr == 1) PG8_BAR; }
    }
    PG8_WAIT_V(0);
    if constexpr (!ALIGN_EPI) { if (wr == 0) PG8_BAR; }
    PG8_BAR;
#undef PG8_SA
#undef PG8_SB
#undef PG8_STAGE
#undef PG8_LDA
#undef PG8_LDB
#undef PG8_MMA
#undef PG8_WAIT_V
#undef PG8_WAIT_L
#undef PG8_BAR
#undef PG8_SCHED
#undef PG8_ROWOFF_G
#undef PG8_TABLD
}
}
using pg8::Unit;

#define XB_TMO      128
#define XB_XCNT(j)  (256  + 64 * (j))
#define XB_XSUB(j)  (1280 + 64 * (j))
#define XB_XGEN(j)  (2304 + 64 * (j))
#define XB_TOP      3328
#define XB_TOPGEN   3392
#define XCD_BAR_WORDS 3456
#define XB_SPIN_CAP (1u << 18)
__device__ __forceinline__ unsigned xb_ld(unsigned* p)              { return __hip_atomic_load(p, __ATOMIC_RELAXED, __HIP_MEMORY_SCOPE_AGENT); }
__device__ __forceinline__ unsigned xb_add(unsigned* p, unsigned v) { return __hip_atomic_fetch_add(p, v, __ATOMIC_RELAXED, __HIP_MEMORY_SCOPE_AGENT); }
__device__ __forceinline__ unsigned xb_xcc_id() { return (unsigned)__builtin_amdgcn_s_getreg((3 << 11) | 20) & 0xFu; }
#define XB_SPIN(cond, bar) do { unsigned _sp = 0; while (cond) { __builtin_amdgcn_s_sleep(1); \
    if ((++_sp & 255u) == 0u) { if (xb_ld(&(bar)[XB_TMO])) break; if (_sp > XB_SPIN_CAP) { atomicAdd(&(bar)[XB_TMO], 1u); break; } } } } while (0)
struct XcdBarrier { unsigned* bar; unsigned x; volatile LAS unsigned* st; };
__device__ __forceinline__ XcdBarrier xcd_barrier_post(unsigned* bar, volatile LAS unsigned* st) {
    XcdBarrier b; b.bar = bar; b.x = xb_xcc_id(); b.st = st;
    if (threadIdx.x == 0) (void)xb_add(&bar[XB_XCNT(b.x)], 1u);
    return b;
}
__device__ __forceinline__ void xcd_barrier_complete(unsigned* bar, unsigned x, unsigned& nloc, unsigned& nx) {
    const unsigned G = gridDim.x * gridDim.y * gridDim.z;
    unsigned sum, cnt, mine, sp = 0u;
    for (;;) {
        sum = 0u; cnt = 0u; mine = 0u;
#pragma unroll
        for (unsigned j = 0; j < 16; ++j) { const unsigned c = xb_ld(&bar[XB_XCNT(j)]); sum += c; cnt += (c > 0u) ? 1u : 0u; mine = (j == x) ? c : mine; }
        if (sum == G) break;
        __builtin_amdgcn_s_sleep(1);
        if ((++sp & 255u) == 0u) { if (xb_ld(&bar[XB_TMO])) break; if (sp > XB_SPIN_CAP) { atomicAdd(&bar[XB_TMO], 1u); break; } }
    }
    nloc = mine > 0u ? mine : 1u; nx = cnt > 0u ? cnt : 1u;
}
__device__ __forceinline__ void xcd_barrier(const XcdBarrier& b) {
    asm volatile("s_waitcnt vmcnt(0)" ::: "memory");
    __syncthreads();
    if (threadIdx.x == 0) {
        unsigned* bar = b.bar;
        __builtin_amdgcn_s_waitcnt(0);
        unsigned nloc = b.st[0], nx = b.st[1];
        if (nloc == 0u) { xcd_barrier_complete(bar, b.x, nloc, nx); b.st[0] = nloc; b.st[1] = nx; }
        const unsigned old = xb_add(&bar[XB_XSUB(b.x)], 1u);
        const unsigned gen = old / nloc;
        if (old + 1u == (gen + 1u) * nloc) {
            __builtin_amdgcn_fence(__ATOMIC_RELEASE, "agent");
            asm volatile("s_waitcnt vmcnt(0)" ::: "memory");
            const unsigned og = xb_add(&bar[XB_TOP], 1u);
            const unsigned tg = og / nx;
            if (og + 1u == (tg + 1u) * nx) xb_add(&bar[XB_TOPGEN], 1u);
            else XB_SPIN(xb_ld(&bar[XB_TOPGEN]) == tg, bar);
            __builtin_amdgcn_fence(__ATOMIC_ACQUIRE, "agent");
            xb_add(&bar[XB_XGEN(b.x)], 1u);
            asm volatile("s_waitcnt vmcnt(0)" ::: "memory");
        } else {
            XB_SPIN(xb_ld(&bar[XB_XGEN(b.x)]) == gen, bar);
            __builtin_amdgcn_fence(__ATOMIC_ACQUIRE, "agent");
            asm volatile("s_waitcnt vmcnt(0)" ::: "memory");
        }
    }
    __syncthreads();
}

struct Frame {
    LAS unsigned char* lds;
    volatile LAS unsigned* MISC;
    unsigned* ctl;
    int tid, lane, wave, vcu, G;
    unsigned char* ws;
};
enum { I_X = 0, I_MEM, I_NORM_MIX, I_W_IN, I_W_POOL, I_POOL_SCALE, I_W_OUT, I_NORM_CROSS, I_NORM_MEM, I_WQ, I_WK, I_WV, I_WO, I_NORM_FFN, I_W_GROUP, I_W_EXPERT, I_W_GATE, I_W_UP, I_W_DOWN, I_NORM_FINAL };

__device__ __forceinline__ void p0_transpose_item(const float* W, int ldw, int k0, int n0, const float* gain, bf16_t* dst, int ldd, LAS float* scr, int lane) {
    f32x4 v[8]; float g[8];
    const int c4 = (lane & 7) * 4, kr = lane >> 3;
#pragma unroll
    for (int i = 0; i < 8; ++i) { v[i] = *(const f32x4*)(W + (size_t)(k0 + kr + 8 * i) * ldw + n0 + c4); g[i] = gain ? gain[k0 + kr + 8 * i] : 1.f; }
#pragma unroll
    for (int i = 0; i < 8; ++i) { LAS float* p = scr + (kr + 8 * i) * 33 + c4; p[0] = v[i].x * g[i]; p[1] = v[i].y * g[i]; p[2] = v[i].z * g[i]; p[3] = v[i].w * g[i]; }
    LDS_WAIT(); asm volatile("" ::: "memory");
    const int c = lane & 7;
#pragma unroll
    for (int j = 0; j < 4; ++j) { const int n = (lane >> 3) + 8 * j; const LAS float* s = scr + (8 * c) * 33 + n;
        u32x4 o; o.x = pk2(s[0 * 33], s[1 * 33]); o.y = pk2(s[2 * 33], s[3 * 33]); o.z = pk2(s[4 * 33], s[5 * 33]); o.w = pk2(s[6 * 33], s[7 * 33]);
        *(u32x4*)(dst + (size_t)n * ldd + 8 * c) = o; }
    LDS_WAIT(); asm volatile("" ::: "memory");
}
__device__ __forceinline__ void rms_rows4_to_bf16(const float* xrow, const float* gain, bf16_t* orow, int lane) {
    f32x4 v[4][4]; float s[4];
#pragma unroll
    for (int q = 0; q < 4; ++q)
#pragma unroll
        for (int j = 0; j < 4; ++j) v[q][j] = ((const f32x4*)(xrow + (size_t)q * D) + lane)[64 * j];
    const f32x4* gr = (const f32x4*)gain + lane; f32x4 g[4];
#pragma unroll
    for (int j = 0; j < 4; ++j) g[j] = gr[64 * j];
#pragma unroll
    for (int q = 0; q < 4; ++q) { float t = 0.f;
#pragma unroll
        for (int j = 0; j < 4; ++j) t += (v[q][j].x * v[q][j].x + v[q][j].y * v[q][j].y) + (v[q][j].z * v[q][j].z + v[q][j].w * v[q][j].w);
        s[q] = 1.0f / sqrtf(wave_sum(t) * (1.f / D) + RMS_EPS); }
#pragma unroll
    for (int q = 0; q < 4; ++q) { u32x2* o8 = (u32x2*)(orow + (size_t)q * D) + lane; const float r = s[q];
#pragma unroll
        for (int j = 0; j < 4; ++j) { u32x2 w; w.x = pk2(v[q][j].x * r * g[j].x, v[q][j].y * r * g[j].y); w.y = pk2(v[q][j].z * r * g[j].z, v[q][j].w * r * g[j].w); o8[64 * j] = w; } }
}
__device__ __forceinline__ void p0_prologue(Frame& F, const float* const* in) {
    LAS float* scr = (LAS float*)(F.lds + F.wave * 16384);
    const int gw = F.vcu * NWAVES + F.wave, NGW = F.G * NWAVES;
    unsigned char* ws = F.ws;
    constexpr int I_IN = 16 * 64, I_SQ = 16 * 32, I_POOL = 4 * 2 * 4, I_GATE = 16 * 16 * 16, I_DOWN = 16 * 8 * 32;
    constexpr int NITEMS = I_IN + 5 * I_SQ + I_POOL + 2 * I_GATE + I_DOWN;
    for (int it = gw; it < NITEMS; it += NGW) {
        int r = it, src, gsrc = -1, ldw, k0, n0, ldd; size_t soff = 0, doff;
        if (r < I_IN) { const int kb = r / 64, nb = r % 64; src = I_W_IN; ldw = INW; k0 = 64 * kb; n0 = 32 * nb; ldd = D; doff = WS_WIN + ((size_t)n0 * D + k0) * 2; }
        else if ((r -= I_IN) < 5 * I_SQ) { const int which = r / I_SQ, q = r % I_SQ, kb = q / 32, nb = q % 32; ldw = D; k0 = 64 * kb; n0 = 32 * nb; ldd = D;
            src = which == 0 ? I_W_OUT : which == 1 ? I_WQ : which == 2 ? I_WK : which == 3 ? I_WV : I_WO; if (which == 1) gsrc = I_NORM_CROSS;
            const size_t base = which == 0 ? WS_WOUT : which == 1 ? WS_WQ : which == 2 ? WS_WKV : which == 3 ? WS_WKV + (size_t)1024 * D * 2 : WS_WO;
            doff = base + ((size_t)n0 * D + k0) * 2; }
        else if ((r -= 5 * I_SQ) < I_POOL) { const int g = r / 8, q = r % 8, kb = q / 4, nb = q % 4; src = I_W_POOL; soff = (size_t)g * 128 * 128; ldw = 128; k0 = 64 * kb; n0 = 32 * nb; ldd = 128;
            doff = WS_WP + ((size_t)g * 128 * 128 + (size_t)n0 * 128 + k0) * 2; }
        else if ((r -= I_POOL) < 2 * I_GATE) { const int up = r / I_GATE, q = r % I_GATE, e = q / 256, q2 = q % 256, kb = q2 / 16, nb = q2 % 16; src = up ? I_W_UP : I_W_GATE; gsrc = I_NORM_FFN;
            soff = (size_t)e * D * 512; ldw = 512; k0 = 64 * kb; n0 = 32 * nb; ldd = D; const int drow = (n0 >> 7) * 256 + up * 128 + (n0 & 127);
            doff = WS_GU + (((size_t)e * 1024 + drow) * D + k0) * 2; }
        else { r -= 2 * I_GATE; const int e = r / 256, q2 = r % 256, kb = q2 / 32, nb = q2 % 32; src = I_W_DOWN; soff = (size_t)e * 512 * D; ldw = D; k0 = 64 * kb; n0 = 32 * nb; ldd = 512;
            doff = WS_WD + (((size_t)e * 1024 + n0) * 512 + k0) * 2; }
        const float* W = in[src] + soff; const float* gain = gsrc >= 0 ? in[gsrc] : nullptr;
        p0_transpose_item(W, ldw, k0, n0, gain, (bf16_t*)(ws + doff), ldd, scr, F.lane);
    }
    {
        bf16_t* wr = (bf16_t*)(ws + WS_WR); const int gt = F.vcu * 512 + F.tid, NT = F.G * 512;
        for (int idx = gt; idx < 32 * D; idx += NT) { const int m = idx >> 10, k = idx & 1023; float v = 0.f;
            if (m < 4) v = in[I_W_GROUP][k * 4 + m] * in[I_NORM_FFN][k]; else if (m >= 8 && m < 24) v = in[I_W_EXPERT][k * 16 + (m - 8)] * in[I_NORM_FFN][k];
            const unsigned h = f2bf(v); const float hf = __builtin_bit_cast(float, h << 16); const unsigned l = f2bf(v - hf);
            wr[idx] = (bf16_t)h; wr[32 * D + idx] = (bf16_t)l; }
    }
    for (int m = gw * 4; m < NTOK; m += NGW * 4) rms_rows4_to_bf16(in[I_X] + (size_t)m * D, in[I_NORM_MIX], (bf16_t*)(ws + WS_RA) + (size_t)m * D, F.lane);
    for (int m = gw * 4; m < MEMROWS; m += NGW * 4) rms_rows4_to_bf16(in[I_MEM] + (size_t)m * D, in[I_NORM_MEM], (bf16_t*)(ws + WS_MEMN) + (size_t)m * D, F.lane);
}

struct SchedP1 {
    const char* XN; const char* WIN; char* QKU; char* VT; int G, c;
    __device__ __forceinline__ bool next(int i, Unit& u) const {
        const int L = i * G + c; if (L >= 1024) return false;
        u.flags = 3; u.aux0 = 0; u.aux1 = 0; u.aux2 = 0;
        if (L < 768) { int pm, pn; pg8::map_std(128, 6, L, pm, pn); u.pm = pm; u.pn = pn;
            u.A = XN + (size_t)pm * 256 * D * 2; u.B = WIN + (size_t)pn * 256 * D * 2; u.O = QKU + ((size_t)pm * 256 * QKU_LD + pn * 256) * 2; u.ldc = QKU_LD; u.scale = (pn == 2 || pn == 3) ? QSCALE_SB : 1.f; }
        else { const int l2 = L - 768, pm = l2 >> 7, pn = l2 & 127; u.pm = pm; u.pn = pn;
            u.A = WIN + (size_t)(1536 + pm * 256) * D * 2; u.B = XN + (size_t)pn * 256 * D * 2; u.O = VT + ((size_t)pm * 256 * NTOK + pn * 256) * 2; u.ldc = NTOK; u.scale = 1.f; }
        return true;
    }
};
struct SchedMemKV {
    const char* MEMN; const char* WKV; char* KMEM; char* VMT; int G, c;
    __device__ __forceinline__ bool next(int i, Unit& u) const {
        const int L = i * G + c; if (L >= 32) return false;
        u.flags = 3; u.aux0 = 0; u.aux1 = 0; u.aux2 = 0; u.ldc = 1024; u.scale = 1.f;
        const int l2 = L & 15, pm = l2 >> 2, pn = l2 & 3; u.pm = pm; u.pn = pn;
        if (L < 16) { u.A = MEMN + (size_t)pm * 256 * D * 2; u.B = WKV + (size_t)pn * 256 * D * 2; u.O = KMEM + ((size_t)pm * 256 * 1024 + pn * 256) * 2; }
        else { u.A = WKV + (size_t)(1024 + pm * 256) * D * 2; u.B = MEMN + (size_t)pn * 256 * D * 2; u.O = VMT + ((size_t)pm * 256 * 1024 + pn * 256) * 2; }
        return true;
    }
};
struct SchedStd {
    const char* A; const char* B; bf16_t* Obase; int G, c;
    __device__ __forceinline__ bool next(int i, Unit& u) const {
        const int L = i * G + c; if (L >= 512) return false;
        int pm, pn; pg8::map_std(128, 4, L, pm, pn); u.pm = pm; u.pn = pn; u.flags = 3; u.aux0 = 0; u.aux1 = 0; u.aux2 = 0; u.O = Obase ? (char*)(Obase + (size_t)pm * 256 * D + pn * 256) : nullptr; u.ldc = D; u.scale = 1.f;
        u.A = A + (size_t)pm * 256 * D * 2; u.B = B + (size_t)pn * 256 * D * 2; return true;
    }
};
__device__ __forceinline__ void moe_decode_tile(volatile LAS unsigned* MISC, int tile, int& c, int& lt, int& nvalid) {
    c = 0;
#pragma unroll 1
    for (int k = 1; k < NCOMBO; ++k) if ((int)MISC[MW_TP + k] <= tile) c = k;
    lt = tile - (int)MISC[MW_TP + c]; const int rem = (int)MISC[MW_CNT + c] - lt * 256; nvalid = rem < 256 ? rem : 256;
}
__device__ __forceinline__ int pair_lo(int p) { return p < 3 ? 0 : (p < 5 ? 1 : 2); }
__device__ __forceinline__ int pair_hi(int p) { return p < 3 ? p + 1 : (p < 5 ? p - 1 : 3); }
struct SchedP8 {
    volatile LAS unsigned* MISC; const char* H2; const char* GU; char* HH; const f32x4* RINFO; int G, c;
    __device__ __forceinline__ bool next(int i, Unit& u) const {
        const int L = i * G + c, T = (int)MISC[MW_TP + NCOMBO]; if (L >= T * 8) return false;
        const int tile = L >> 3, pn = L & 7; int cb, lt, nv; moe_decode_tile(MISC, tile, cb, lt, nv);
        const int g = cb / 6, p = cb % 6, s = pn >> 2, ch = pn & 3, e = 4 * g + (s ? pair_hi(p) : pair_lo(p));
        u.A = H2; u.B = GU + ((size_t)e * 1024 + ch * 256) * D * 2; u.O = HH + ((size_t)tile * 256 * D + s * 512 + ch * 128) * 2; u.ldc = D; u.scale = 1.f;
        u.pm = tile; u.pn = pn; u.flags = 3; u.aux0 = cb * NTOK + lt * 256; u.aux1 = nv; u.aux2 = s; return true;
    }
    __device__ __forceinline__ const unsigned* tokptr(const Unit& u, int r) const { const int rr = r < u.aux1 ? r : u.aux1 - 1; return (const unsigned*)(RINFO + (u.aux0 + rr)) + 3; }
};
struct SchedP9 {
    volatile LAS unsigned* MISC; const char* HH; const char* WD; int G, c;
    __device__ __forceinline__ bool next(int i, Unit& u) const {
        const int L = (i >> 1) * G + c, ks = i & 1, T = (int)MISC[MW_TP + NCOMBO]; if (L >= T * 4) return false;
        const int tile = L >> 2, pn = L & 3; int cb, lt, nv; moe_decode_tile(MISC, tile, cb, lt, nv);
        const int g = cb / 6, p = cb % 6, e = 4 * g + (ks ? pair_hi(p) : pair_lo(p));
        u.A = HH + ((size_t)tile * 256 * D + ks * 512) * 2; u.B = WD + ((size_t)e * 1024 + pn * 256) * 512 * 2; u.O = nullptr; u.ldc = D; u.scale = 1.f;
        u.pm = tile; u.pn = pn; u.flags = ks ? 2 : 1; u.aux0 = cb * NTOK + lt * 256; u.aux1 = nv; u.aux2 = ks; return true;
    }
};

__device__ __forceinline__ u32x4 ldg16(const void* base, unsigned off) { return *(const u32x4*)((const char*)base + off); }
__device__ __forceinline__ f32x4 ldg16f(const void* base, unsigned off) { return *(const f32x4*)((const char*)base + off); }
__device__ __forceinline__ void stg16(void* base, unsigned off, u32x4 v) { *(u32x4*)((char*)base + off) = v; }
__device__ __forceinline__ void stg16f(void* base, unsigned off, f32x4 v) { *(f32x4*)((char*)base + off) = v; }
__device__ __forceinline__ float sum16(const void* base, unsigned off) {
    const f32x4 a = ldg16f(base, off), b = ldg16f(base, off + 16), c = ldg16f(base, off + 32), d = ldg16f(base, off + 48);
    return ((a.x + a.y) + (a.z + a.w)) + ((b.x + b.y) + (b.z + b.w)) + ((c.x + c.y) + (c.z + c.w)) + ((d.x + d.y) + (d.z + d.w));
}
__device__ __forceinline__ u32x4 pack8(const f32x4 v0, const f32x4 v1) { u32x4 w; w.x = cvtpk(v0[0], v0[1]); w.y = cvtpk(v0[2], v0[3]); w.z = cvtpk(v1[0], v1[1]); w.w = cvtpk(v1[2], v1[3]); return w; }
__device__ __forceinline__ float sq8(const f32x4 v0, const f32x4 v1) { return (v0[0] * v0[0] + v0[1] * v0[1]) + (v0[2] * v0[2] + v0[3] * v0[3]) + (v1[0] * v1[0] + v1[1] * v1[1]) + (v1[2] * v1[2] + v1[3] * v1[3]); }
struct EpiStore {
    const float* ss; float rowmul;
    __device__ __forceinline__ void operator()(const f32x4 (&acc)[2][2][4][2], const Unit& u, int wr, int wc, int fr, int fq) const {
        const unsigned lcol = (unsigned)(wc * 32 + 8 * fq) * 2u;
#pragma unroll
        for (int ai = 0; ai < 2; ++ai)
#pragma unroll
            for (int m = 0; m < 4; ++m) { const int r = ai * 128 + wr * 64 + m * 16 + fr; float sc = u.scale;
                if (ss) { const float t = sum16(ss, (unsigned)(u.pm * 256 + r) * 64u); sc = rowmul / sqrtf(t * (1.f / D) + RMS_EPS); }
                const unsigned ro = (unsigned)(r * u.ldc) * 2u + lcol;
#pragma unroll
                for (int bj = 0; bj < 2; ++bj) stg16(u.O, ro + bj * 256, pack8(acc[ai][bj][m][0] * sc, acc[ai][bj][m][1] * sc)); }
    }
};
template <bool RESF32> struct EpiRes {
    const void* res; bf16_t* out; float* ss;
    __device__ __forceinline__ void operator()(const f32x4 (&acc)[2][2][4][2], const Unit& u, int wr, int wc, int fr, int fq) const {
        const int col0 = u.pn * 256 + wc * 32 + 8 * fq;
#pragma unroll
        for (int ai = 0; ai < 2; ++ai)
#pragma unroll
            for (int m = 0; m < 4; ++m) { const int grow = u.pm * 256 + ai * 128 + wr * 64 + m * 16 + fr; float sq = 0.f;
#pragma unroll
                for (int bj = 0; bj < 2; ++bj) { const unsigned eoff = (unsigned)(grow * D + col0 + bj * 128); f32x4 r0, r1;
                    if constexpr (RESF32) { r0 = ldg16f(res, eoff * 4u); r1 = ldg16f(res, eoff * 4u + 16u); }
                    else { const u32x4 w = ldg16(res, eoff * 2u); r0 = (f32x4){bflo(w.x), bfhi(w.x), bflo(w.y), bfhi(w.y)}; r1 = (f32x4){bflo(w.z), bfhi(w.z), bflo(w.w), bfhi(w.w)}; }
                    const f32x4 v0 = acc[ai][bj][m][0] + r0, v1 = acc[ai][bj][m][1] + r1;
                    sq += sq8(v0, v1);
                    stg16(out, eoff * 2u, pack8(v0, v1)); }
                sq += __shfl_xor(sq, 16); sq += __shfl_xor(sq, 32);
                if (fq == 0) *(float*)((char*)ss + (unsigned)(grow * 16 + u.pn * 4 + wc) * 4u) = sq; }
    }
};
struct EpiGU {
    const f32x4* rinfo;
    __device__ __forceinline__ void operator()(const f32x4 (&acc)[2][2][4][2], const Unit& u, int wr, int wc, int fr, int fq) const {
        const unsigned lcol = (unsigned)(wc * 32 + 8 * fq) * 2u;
#pragma unroll
        for (int ai = 0; ai < 2; ++ai)
#pragma unroll
            for (int m = 0; m < 4; ++m) { const int r = ai * 128 + wr * 64 + m * 16 + fr; const int rr = r < u.aux1 ? r : u.aux1 - 1;
                const f32x4 info = ldg16f(rinfo, (unsigned)(u.aux0 + rr) * 16u); const float rs = info.x, wgt = u.aux2 ? info.z : info.y;
                f32x4 h0, h1;
#pragma unroll
                for (int j = 0; j < 4; ++j) { const float g0 = acc[ai][0][m][0][j] * rs, u0 = acc[ai][1][m][0][j] * rs, g1 = acc[ai][0][m][1][j] * rs, u1 = acc[ai][1][m][1][j] * rs;
                    h0[j] = g0 * __builtin_amdgcn_rcpf(1.f + __builtin_amdgcn_exp2f(-g0 * LOG2E)) * u0 * wgt;
                    h1[j] = g1 * __builtin_amdgcn_rcpf(1.f + __builtin_amdgcn_exp2f(-g1 * LOG2E)) * u1 * wgt; }
                stg16(u.O, (unsigned)(r * u.ldc) * 2u + lcol, pack8(h0, h1)); }
    }
};
struct EpiDown {
    const f32x4* rinfo; const bf16_t* h2; float* out; float* ss;
    __device__ __forceinline__ void operator()(const f32x4 (&acc)[2][2][4][2], const Unit& u, int wr, int wc, int fr, int fq) const {
        const int col0 = u.pn * 256 + wc * 32 + 8 * fq;
#pragma unroll
        for (int ai = 0; ai < 2; ++ai)
#pragma unroll
            for (int m = 0; m < 4; ++m) { const int r = ai * 128 + wr * 64 + m * 16 + fr; const bool valid = r < u.aux1; const int rr = valid ? r : u.aux1 - 1;
                const int tok = __builtin_bit_cast(int, ldg16f(rinfo, (unsigned)(u.aux0 + rr) * 16u).w); float sq = 0.f;
#pragma unroll
                for (int bj = 0; bj < 2; ++bj) { const unsigned eoff = (unsigned)(tok * D + col0 + bj * 128);
                    const u32x4 w = ldg16(h2, eoff * 2u);
                    const f32x4 v0 = acc[ai][bj][m][0] + (f32x4){bflo(w.x), bfhi(w.x), bflo(w.y), bfhi(w.y)}, v1 = acc[ai][bj][m][1] + (f32x4){bflo(w.z), bfhi(w.z), bflo(w.w), bfhi(w.w)};
                    sq += sq8(v0, v1);
                    if (valid) { stg16f(out, eoff * 4u, v0); stg16f(out, eoff * 4u + 16u, v1); } }
                sq += __shfl_xor(sq, 16); sq += __shfl_xor(sq, 32);
                if (fq == 0 && valid) *(float*)((char*)ss + (unsigned)(tok * 16 + u.pn * 4 + wc) * 4u) = sq; }
    }
};

__device__ __forceinline__ void sb_attn_unit(const bf16_t* __restrict__ QKU, const bf16_t* __restrict__ VT, bf16_t* __restrict__ MIX, int u, int lane) {
    asm volatile("" : "+v"(lane));
    const int b = u >> 11, h = (u >> 8) & 7, qg = u & 255, r = lane & 31, hi = lane >> 5;
    const size_t tok0 = (size_t)b * SEQ;
    const bf16_t* qp = QKU + (tok0 + qg * 32 + r) * QKU_LD + 512 + h * 64 + 8 * hi;
    bf16x8 qf[4];
#pragma unroll
    for (int ks = 0; ks < 4; ++ks) qf[ks] = *(const bf16x8*)(qp + 16 * ks);
    f32x16 o0, o1;
#pragma unroll
    for (int i = 0; i < 16; ++i) { o0[i] = 0.f; o1[i] = 0.f; }
    float carry = 1.f;
    const int kperm = (r & 0x13) | ((r & 4) << 1) | ((r & 8) >> 1);
    const bf16_t* kbase = QKU + (tok0 + kperm) * QKU_LD + 1024 + h * 64 + 8 * hi;
    const bf16_t* vbase = VT + (size_t)(h * 64 + r) * NTOK + tok0 + 8 * hi;
    const int t = qg * 32 + r;
    bf16x8 kf[4], v00, v01, v10, v11;
    { const bf16_t* kp = kbase + (size_t)qg * 32 * QKU_LD; const bf16_t* vp = vbase + qg * 32;
#pragma unroll
      for (int ks = 0; ks < 4; ++ks) kf[ks] = *(const bf16x8*)(kp + 16 * ks);
      v00 = *(const bf16x8*)(vp); v01 = *(const bf16x8*)(vp + 16); v10 = *(const bf16x8*)(vp + (size_t)32 * NTOK); v11 = *(const bf16x8*)(vp + (size_t)32 * NTOK + 16); }
    for (int kt = qg;;) {
        const int kn = kt > 0 ? kt - 1 : 0;
        const bf16_t* kp = kbase + (size_t)kn * 32 * QKU_LD; const bf16_t* vp = vbase + kn * 32;
        bf16x8 nkf[4];
#pragma unroll
        for (int ks = 0; ks < 4; ++ks) nkf[ks] = *(const bf16x8*)(kp + 16 * ks);
        const bf16x8 n00 = *(const bf16x8*)(vp), n01 = *(const bf16x8*)(vp + 16), n10 = *(const bf16x8*)(vp + (size_t)32 * NTOK), n11 = *(const bf16x8*)(vp + (size_t)32 * NTOK + 16);
        __builtin_amdgcn_sched_barrier(0);
        f32x16 s;
#pragma unroll
        for (int i = 0; i < 16; ++i) s[i] = 0.f;
#pragma unroll
        for (int ks = 0; ks < 4; ++ks) s = MFMA32(kf[ks], qf[ks], s);
        float wt[16];
        const bool diag = (kt == qg);
        float Ta = 1.f, Tb = 1.f;
#pragma unroll
        for (int i = 7; i >= 0; --i) {
            { const int key = kt * 32 + 8 * hi + i; float ee = __builtin_amdgcn_exp2f(fminf(s[i], 100.f)); float rr = __builtin_amdgcn_rcpf(1.f + ee);
              if (diag && key >= t) { ee = 0.f; rr = 1.f; }
              Ta *= rr; wt[i] = ee * Ta; }
            { const int key = kt * 32 + 16 + 8 * hi + i; float ee = __builtin_amdgcn_exp2f(fminf(s[8 + i], 100.f)); float rr = __builtin_amdgcn_rcpf(1.f + ee);
              if (diag && key >= t) { ee = 0.f; rr = 1.f; }
              Tb *= rr; wt[8 + i] = ee * Tb; }
        }
        const float pTa = __shfl_xor(Ta, 32), pTb = __shfl_xor(Tb, 32);
        const float offb = hi ? carry : carry * pTb;
        const float offa = hi ? carry * Tb * pTb : carry * pTb * Tb * pTa;
        carry = carry * ((Ta * Tb) * (pTa * pTb));
        u32x4 w0, w1;
        w0.x = cvtpk(wt[0] * offa, wt[1] * offa); w0.y = cvtpk(wt[2] * offa, wt[3] * offa); w0.z = cvtpk(wt[4] * offa, wt[5] * offa); w0.w = cvtpk(wt[6] * offa, wt[7] * offa);
        w1.x = cvtpk(wt[8] * offb, wt[9] * offb); w1.y = cvtpk(wt[10] * offb, wt[11] * offb); w1.z = cvtpk(wt[12] * offb, wt[13] * offb); w1.w = cvtpk(wt[14] * offb, wt[15] * offb);
        const bf16x8 wa = __builtin_bit_cast(bf16x8, w0), wb = __builtin_bit_cast(bf16x8, w1);
        o0 = MFMA32(v00, wa, o0); o0 = MFMA32(v01, wb, o0); o1 = MFMA32(v10, wa, o1); o1 = MFMA32(v11, wb, o1);
        __builtin_amdgcn_sched_barrier(0);
#pragma unroll
        for (int ks = 0; ks < 4; ++ks) kf[ks] = nkf[ks];
        v00 = n00; v01 = n01; v10 = n10; v11 = n11;
        if (kt == 0 || __all(carry < 7.8e-31f)) break;
        --kt;
    }
    asm volatile("" :: "v"(kf[0]), "v"(kf[1]), "v"(kf[2]), "v"(kf[3]), "v"(v00), "v"(v01), "v"(v10), "v"(v11));
    bf16_t* op = MIX + (tok0 + qg * 32 + r) * D + 512 + h * 64 + 4 * hi;
#pragma unroll
    for (int g = 0; g < 4; ++g) { u32x2 a, c; a.x = cvtpk(o0[4 * g], o0[4 * g + 1]); a.y = cvtpk(o0[4 * g + 2], o0[4 * g + 3]); c.x = cvtpk(o1[4 * g], o1[4 * g + 1]); c.y = cvtpk(o1[4 * g + 2], o1[4 * g + 3]);
        *(u32x2*)(op + 8 * g) = a; *(u32x2*)(op + 32 + 8 * g) = c; }
}
template <int W> struct PoolRegs { u32x4 x[W]; bf16x8 a[4]; };
template <int W> __device__ __forceinline__ void pool_load(PoolRegs<W>& R, const bf16_t* up, const bf16_t* wp, int nwin, int ks) {
#pragma unroll
    for (int i = 0; i < W; ++i) { const int back = i < nwin ? i : 0; R.x[i] = *(const u32x4*)(up + 16 * ks - (size_t)back * QKU_LD); }
#pragma unroll
    for (int mb = 0; mb < 4; ++mb) R.a[mb] = *(const bf16x8*)(wp + (size_t)mb * 32 * 128 + 16 * ks);
}
template <int W> __device__ __forceinline__ void pool_compute(const PoolRegs<W>& R, f32x16 (&acc)[4], int nwin, float inv) {
    float sm[8];
#pragma unroll
    for (int j = 0; j < 8; ++j) sm[j] = 0.f;
#pragma unroll
    for (int i = 0; i < W; ++i) { const float m = i < nwin ? 1.f : 0.f; const u32x4 x = R.x[i];
        sm[0] += m * bflo(x.x); sm[1] += m * bfhi(x.x); sm[2] += m * bflo(x.y); sm[3] += m * bfhi(x.y); sm[4] += m * bflo(x.z); sm[5] += m * bfhi(x.z); sm[6] += m * bflo(x.w); sm[7] += m * bfhi(x.w); }
    const u32x4 self = R.x[0];
    u32x4 o; o.x = cvtpk(sm[0] * inv - bflo(self.x), sm[1] * inv - bfhi(self.x)); o.y = cvtpk(sm[2] * inv - bflo(self.y), sm[3] * inv - bfhi(self.y));
    o.z = cvtpk(sm[4] * inv - bflo(self.z), sm[5] * inv - bfhi(self.z)); o.w = cvtpk(sm[6] * inv - bflo(self.w), sm[7] * inv - bfhi(self.w));
    const bf16x8 pf = __builtin_bit_cast(bf16x8, o);
#pragma unroll
    for (int mb = 0; mb < 4; ++mb) acc[mb] = MFMA32(R.a[mb], pf, acc[mb]);
}
template <int G> __device__ __forceinline__ void pool_unit_g(const bf16_t* __restrict__ QKU, const bf16_t* __restrict__ WPT_, const float* __restrict__ pscale_, bf16_t* __restrict__ MIX, int tg, int lane) {
    constexpr int W = 2 << G;
    asm volatile("" : "+s"(pscale_), "+s"(WPT_), "+v"(lane));
    const GAS float* pscale = (const GAS float*)pscale_; const GAS bf16_t* WPT = (const GAS bf16_t*)WPT_;
    const int r = lane & 31, hi = lane >> 5;
    const int tok = tg * 32 + r, t = tok & (SEQ - 1);
    const int nwin = (t + 1) < W ? (t + 1) : W; const float inv = 1.f / (float)nwin;
    const bf16_t* up = QKU + (size_t)tok * QKU_LD + G * 128 + 8 * hi;
    const bf16_t* wp = (const bf16_t*)(WPT + (size_t)G * 128 * 128 + (size_t)r * 128 + 8 * hi);
    f32x16 acc[4];
#pragma unroll
    for (int mb = 0; mb < 4; ++mb)
#pragma unroll
        for (int i = 0; i < 16; ++i) acc[mb][i] = 0.f;
    if constexpr (W <= 8) {
        PoolRegs<W> RA, RB;
        pool_load<W>(RA, up, wp, nwin, 0);
#pragma unroll 1
        for (int ks = 0; ks < 8; ks += 2) {
            pool_load<W>(RB, up, wp, nwin, ks + 1);
            __builtin_amdgcn_sched_barrier(0);
            pool_compute<W>(RA, acc, nwin, inv);
            __builtin_amdgcn_sched_barrier(0);
            pool_load<W>(RA, up, wp, nwin, ks + 2 < 8 ? ks + 2 : 7);
            __builtin_amdgcn_sched_barrier(0);
            pool_compute<W>(RB, acc, nwin, inv);
            __builtin_amdgcn_sched_barrier(0);
        }
    } else {
        PoolRegs<W> RA;
#pragma unroll 1
        for (int ks = 0; ks < 8; ++ks) {
            pool_load<W>(RA, up, wp, nwin, ks);
            __builtin_amdgcn_sched_barrier(0);
            pool_compute<W>(RA, acc, nwin, inv);
            __builtin_amdgcn_sched_barrier(0);
        }
    }
    bf16_t* op = MIX + (size_t)tok * D + G * 128 + 4 * hi;
#pragma unroll
    for (int mb = 0; mb < 4; ++mb)
#pragma unroll
        for (int q = 0; q < 4; ++q) { const f32x4 sc = *(const GAS f32x4*)(pscale + G * 128 + mb * 32 + 8 * q + 4 * hi);
            u32x2 o; o.x = cvtpk(acc[mb][4 * q] * sc.x, acc[mb][4 * q + 1] * sc.y); o.y = cvtpk(acc[mb][4 * q + 2] * sc.z, acc[mb][4 * q + 3] * sc.w);
            *(u32x2*)(op + mb * 32 + 8 * q) = o; }
}
__device__ __forceinline__ void pool_unit(const bf16_t* __restrict__ QKU, const bf16_t* __restrict__ WPT, const float* __restrict__ pscale, bf16_t* __restrict__ MIX, int u, int lane) {
    const int tg = u >> 2, g = u & 3;
    if (g == 0) pool_unit_g<0>(QKU, WPT, pscale, MIX, tg, lane); else if (g == 1) pool_unit_g<1>(QKU, WPT, pscale, MIX, tg, lane);
    else if (g == 2) pool_unit_g<2>(QKU, WPT, pscale, MIX, tg, lane); else pool_unit_g<3>(QKU, WPT, pscale, MIX, tg, lane);
}

constexpr int XROW = 528;
__device__ __forceinline__ void stage256(LAS unsigned char* lds, const bf16_t* src, int ld, int wave, int lane) {
#pragma unroll
    for (int i = 0; i < 17; ++i) {
        const int ins = i * 8 + wave;
        if (ins < 132) { const int j = ins * 64 + lane, R = (j * 1986) >> 16  , pos = j - R * 33, c = pos < 32 ? pos : 0;
            __builtin_amdgcn_global_load_lds((const unsigned*)(src + (size_t)R * ld + c * 8), (LAS unsigned*)(lds + ins * 1024), 16, 0, 0); }
    }
}
__device__ __forceinline__ bf16x8 frag256(LAS unsigned char* lds, int R, int c) { return *(const LAS bf16x8*)(lds + R * XROW + c * 16); }
__device__ __forceinline__ void cross_phase(LAS unsigned char* lds, const bf16_t* __restrict__ QM, const bf16_t* __restrict__ KMEM, const bf16_t* __restrict__ VMT, bf16_t* __restrict__ OC, int vcu, int G, int wave, int lane) {
    const int r = lane & 31, hi = lane >> 5;
    const int kperm = (r & 0x13) | ((r & 4) << 1) | ((r & 8) >> 1);
#pragma unroll 1
    for (int u = vcu; u < (NTOK / 256) * 4; u += G) {
        const int rb = u >> 2, hd = u & 3, tok0 = rb * 256 + wave * 32, b = (rb * 256) >> 13;
        stage256(lds, KMEM + (size_t)(b * 256) * D + hd * 256, D, wave, lane);
        const bf16_t* qp = QM + (size_t)(tok0 + r) * D + hd * 256 + 8 * hi;
        bf16x8 qa[2], qb[2];
#pragma unroll
        for (int k = 0; k < 2; ++k) qa[k] = *(const bf16x8*)(qp + 16 * k);
        VM_WAIT(); __syncthreads();
        f32x16 s[8];
#pragma unroll
        for (int kb = 0; kb < 8; ++kb)
#pragma unroll
            for (int i = 0; i < 16; ++i) s[kb][i] = 0.f;
#define CROSS_S(QF, g) do { _Pragma("unroll") for (int k = 0; k < 2; ++k) _Pragma("unroll") for (int kb = 0; kb < 8; ++kb) { \
            const bf16x8 kf = frag256(lds, kb * 32 + kperm, 2 * ((g) * 2 + k) + hi); s[kb] = MFMA32(kf, QF[k], s[kb]); } } while (0)
#define CROSS_Q(QF, g) do { _Pragma("unroll") for (int k = 0; k < 2; ++k) QF[k] = *(const bf16x8*)(qp + 16 * ((g) * 2 + k)); } while (0)
#define CROSS_STEP(QN, QC, g) do { CROSS_Q(QN, (g) + 1); __builtin_amdgcn_sched_barrier(0); CROSS_S(QC, g); __builtin_amdgcn_sched_barrier(0); } while (0)
        CROSS_STEP(qb, qa, 0); CROSS_STEP(qa, qb, 1); CROSS_STEP(qb, qa, 2); CROSS_STEP(qa, qb, 3); CROSS_STEP(qb, qa, 4); CROSS_STEP(qa, qb, 5); CROSS_STEP(qb, qa, 6);
        CROSS_S(qb, 7);
#undef CROSS_STEP
#undef CROSS_S
#undef CROSS_Q
        float mx = -3.0e38f;
#pragma unroll
        for (int kb = 0; kb < 8; ++kb)
#pragma unroll
            for (int i = 0; i < 16; ++i) mx = fmaxf(mx, s[kb][i]);
        mx = fmaxf(mx, __shfl_xor(mx, 32));
        float sum = 0.f; bf16x8 pf[16];
#pragma unroll
        for (int kb = 0; kb < 8; ++kb) {
            float e[16];
#pragma unroll
            for (int i = 0; i < 16; ++i) { e[i] = __builtin_amdgcn_exp2f(s[kb][i] - mx); sum += e[i]; }
            u32x4 w0, w1; w0.x = cvtpk(e[0], e[1]); w0.y = cvtpk(e[2], e[3]); w0.z = cvtpk(e[4], e[5]); w0.w = cvtpk(e[6], e[7]);
            w1.x = cvtpk(e[8], e[9]); w1.y = cvtpk(e[10], e[11]); w1.z = cvtpk(e[12], e[13]); w1.w = cvtpk(e[14], e[15]);
            pf[2 * kb] = __builtin_bit_cast(bf16x8, w0); pf[2 * kb + 1] = __builtin_bit_cast(bf16x8, w1);
        }
        sum += __shfl_xor(sum, 32);
        const float inv = 1.f / sum;
        __syncthreads();
        stage256(lds, VMT + (size_t)(hd * 256) * 1024 + b * 256, 1024, wave, lane);
        VM_WAIT(); __syncthreads();
        bf16_t* op = OC + (size_t)(tok0 + r) * D + hd * 256 + 4 * hi;
#pragma unroll 1
        for (int dh = 0; dh < 2; ++dh) {
            f32x16 o[4];
#pragma unroll
            for (int db = 0; db < 4; ++db)
#pragma unroll
                for (int i = 0; i < 16; ++i) o[db][i] = 0.f;
#pragma unroll
            for (int ks = 0; ks < 16; ++ks)
#pragma unroll
                for (int db = 0; db < 4; ++db) { const bf16x8 vf = frag256(lds, (dh * 4 + db) * 32 + r, 2 * ks + hi); o[db] = MFMA32(vf, pf[ks], o[db]); }
#pragma unroll
            for (int db = 0; db < 4; ++db)
#pragma unroll
                for (int q = 0; q < 4; ++q) { u32x2 w; w.x = cvtpk(o[db][4 * q] * inv, o[db][4 * q + 1] * inv); w.y = cvtpk(o[db][4 * q + 2] * inv, o[db][4 * q + 3] * inv);
                    *(u32x2*)(op + (dh * 4 + db) * 32 + 8 * q) = w; }
        }
        __syncthreads();
    }
}

__device__ __forceinline__ void router_unit(const bf16_t* __restrict__ H2, const bf16_t* __restrict__ WR, const float* __restrict__ SS2, f32x4* __restrict__ RINFO, unsigned* ctl, int rg, int lane) {
    asm volatile("" : "+v"(lane));
    const int r = lane & 31, hi = lane >> 5, tok = rg * 32 + r;
    const bf16_t* hp = H2 + (size_t)tok * D + 8 * hi;
    const bf16_t* wh = WR + (size_t)r * D + 8 * hi; const bf16_t* wl = wh + 32 * D;
    f32x16 acc;
#pragma unroll
    for (int i = 0; i < 16; ++i) acc[i] = 0.f;
#pragma unroll 4
    for (int ks = 0; ks < 64; ++ks) { const bf16x8 x = *(const bf16x8*)(hp + 16 * ks), a = *(const bf16x8*)(wh + 16 * ks), c = *(const bf16x8*)(wl + 16 * ks);
        acc = MFMA32(a, x, acc); acc = MFMA32(c, x, acc); }
    float xo[8];
#pragma unroll
    for (int i = 0; i < 8; ++i) xo[i] = __shfl_xor(acc[4 + i], 32);
    const f32x4* sp = (const f32x4*)(SS2 + (size_t)tok * 16); const f32x4 a = sp[0], bq = sp[1], c = sp[2], d = sp[3];
    const float tss = ((a.x + a.y) + (a.z + a.w)) + ((bq.x + bq.y) + (bq.z + bq.w)) + ((c.x + c.y) + (c.z + c.w)) + ((d.x + d.y) + (d.z + d.w));
    const float rs = 1.0f / sqrtf(tss * (1.f / D) + RMS_EPS);
    float gl[4] = {acc[0] * rs, acc[1] * rs, acc[2] * rs, acc[3] * rs};
    int gi = 0; float gm = gl[0];
#pragma unroll
    for (int j = 1; j < 4; ++j) if (gl[j] > gm) { gm = gl[j]; gi = j; }
    float gsum = 0.f;
#pragma unroll
    for (int j = 0; j < 4; ++j) gsum += __builtin_amdgcn_exp2f((gl[j] - gm) * LOG2E);
    const float ggate = 1.f / gsum;
    float el[4];
#pragma unroll
    for (int j = 0; j < 4; ++j) { const float e0 = acc[4 + j], e1 = xo[j], e2 = acc[8 + j], e3 = xo[4 + j]; el[j] = (gi == 0 ? e0 : gi == 1 ? e1 : gi == 2 ? e2 : e3) * rs; }
    int i1 = 0; float m1 = el[0];
#pragma unroll
    for (int j = 1; j < 4; ++j) if (el[j] > m1) { m1 = el[j]; i1 = j; }
    int i2 = -1; float m2 = -3.0e38f;
#pragma unroll
    for (int j = 0; j < 4; ++j) if (j != i1 && el[j] > m2) { m2 = el[j]; i2 = j; }
    const float ex = __builtin_amdgcn_exp2f((m2 - m1) * LOG2E); const float w1 = 1.f / (1.f + ex), w2 = ex * w1;
    const int lo = i1 < i2 ? i1 : i2, hh = i1 < i2 ? i2 : i1;
    const float wlo = ggate * (i1 < i2 ? w1 : w2), whi = ggate * (i1 < i2 ? w2 : w1);
    const int pair = lo == 0 ? hh - 1 : (lo == 1 ? hh + 1 : 5);
    const int combo = gi * 6 + pair;
    const bool owner = (hi == 0);
    unsigned mycnt = 0; unsigned long long mymask = 0ull;
#pragma unroll 1
    for (int cb = 0; cb < NCOMBO; ++cb) {
        const unsigned long long mask = __ballot(owner && combo == cb);
        if (lane == cb) mycnt = (unsigned)__popcll(mask);
        if (owner && combo == cb) mymask = mask;
    }
    unsigned base = 0;
    if (lane < NCOMBO && mycnt) base = __hip_atomic_fetch_add(ctl + CW_CNT + 64 * lane, mycnt, RLX_AGENT);
    const unsigned mybase = (unsigned)__shfl((int)base, combo & 63);
    const int pos = (int)mybase + __popcll(mymask & ((1ull << lane) - 1ull));
    if (owner) RINFO[(size_t)combo * NTOK + pos] = (f32x4){rs, wlo, whi, __builtin_bit_cast(float, tok)};
}

struct Args { const float* in[20]; float* out; unsigned char* ws; int ph_lo, ph_hi; };
constexpr int N_PHASES = 11;

__global__ void __launch_bounds__(NWAVES * 64, 2) fwd(Args args) {
    extern __shared__ __attribute__((aligned(16))) unsigned char lds_raw[];
    Frame F;
    F.lds = (LAS unsigned char*)lds_raw;
    F.MISC = (volatile LAS unsigned*)(F.lds + LDSCTL_OFF);
    F.tid = threadIdx.x; F.lane = F.tid & 63; F.wave = __builtin_amdgcn_readfirstlane(F.tid >> 6);
    F.G = gridDim.x; { const int bx = blockIdx.x; F.vcu = (F.G % 8 == 0) ? (bx % 8) * (F.G / 8) + bx / 8 : bx; }
    unsigned char* ws = args.ws; F.ws = ws;
    F.ctl = (unsigned*)(ws + WS_CTL);
    for (int u = F.tid; u < (LDS_BYTES - LDSCTL_OFF) / 4; u += NWAVES * 64) ((LAS unsigned*)(F.lds + LDSCTL_OFF))[u] = 0u;
    __syncthreads();
    const int lo = args.ph_lo, hi = args.ph_hi;
    const bool multi = (hi - lo) > 1;
    XcdBarrier bar; bar.bar = F.ctl + CW_BAR; bar.x = 0; bar.st = nullptr;
    if (multi) bar = xcd_barrier_post(F.ctl + CW_BAR, F.MISC + MW_BAR);
#ifndef PHASE_MASK
#define PHASE_MASK 0x7ff
#endif
#define IN(k) (((PHASE_MASK >> (k)) & 1) && lo <= (k) && (k) < hi)
#define SEAM(k) do { if (IN(k) && IN((k) + 1)) xcd_barrier(bar); } while (0)
#ifndef DUP_MASK
#define DUP_MASK 0
#endif
#define REPS(k) ((((DUP_MASK) >> (k)) & 1) ? 2 : 1)
#define DUPBAR(k, rep) do { if (REPS(k) == 2 && (rep) == 0 && multi) xcd_barrier(bar); } while (0)

    bf16_t* const XN = (bf16_t*)(ws + WS_RA);  bf16_t* const MIX = XN; bf16_t* const QM = XN; bf16_t* const H2 = XN;
    bf16_t* const QKU = (bf16_t*)(ws + WS_RB); bf16_t* const VT = (bf16_t*)(ws + WS_VT);
    bf16_t* const H1 = (bf16_t*)(ws + WS_RB);  bf16_t* const OC = (bf16_t*)(ws + WS_OC); bf16_t* const HH = (bf16_t*)(ws + WS_RB);
    const int gw = F.vcu * NWAVES + F.wave, NGW = F.G * NWAVES;

    if (IN(0)) { _Pragma("unroll") for (int rep = 0; rep < REPS(0); ++rep) { p0_prologue(F, args.in); DUPBAR(0, rep); } }
    SEAM(0);
    if (IN(1)) {
        SchedP1 S{(const char*)XN, (const char*)(ws + WS_WIN), (char*)QKU, (char*)VT, F.G, (int)blockIdx.x};
        EpiStore E{nullptr, 1.f};
        _Pragma("unroll") for (int rep = 0; rep < REPS(1); ++rep) { pg8::gemm_phase<EpiStore, SchedP1, false, true>(F.lds, D, D, D, S, E); DUPBAR(1, rep); }
    }
    SEAM(1);
    if (IN(2)) {
        SchedMemKV S{(const char*)(ws + WS_MEMN), (const char*)(ws + WS_WKV), (char*)(ws + WS_KMEM), (char*)(ws + WS_VMT), F.G, (int)blockIdx.x};
        EpiStore E{nullptr, 1.f};
        constexpr int NATT = NB * 8 * 256, NPOOL = (NTOK / 32) * 4;
        pg8::gemm_phase<EpiStore, SchedMemKV, false, true>(F.lds, D, D, D, S, E);
        _Pragma("unroll") for (int rep = 0; rep < REPS(2); ++rep) {
        constexpr int NUNITS = NATT + NPOOL;
        const int nG = F.G < 32 ? F.G : 32, nO = F.G - nG;
        int s0, s1;
        if (F.G == 256) { const int bx = (int)blockIdx.x; s0 = bx < 32 ? bx * P2_SLOTS_GEMM : 32 * P2_SLOTS_GEMM + (bx - 32) * P2_SLOTS_OTHER; s1 = s0 + (bx < 32 ? P2_SLOTS_GEMM : P2_SLOTS_OTHER); }
        else { const int per = (NUNITS + F.G - 1) / F.G; s0 = (int)blockIdx.x * per; s1 = s0 + per < NUNITS ? s0 + per : NUNITS; (void)nO; }
        LAS unsigned* cursor = (LAS unsigned*)(F.lds + LDSCTL_OFF) + MW_CUR + rep;
        for (;;) {
            unsigned idx = 0; if (F.lane == 0) idx = __hip_atomic_fetch_add(cursor, 1u, __ATOMIC_RELAXED, __HIP_MEMORY_SCOPE_WORKGROUP);
            const int slot = s0 + (int)__builtin_amdgcn_readfirstlane(idx);
            if (slot >= s1) break;
            const int tri = slot / 3, ph = slot - tri * 3;
            const unsigned u = ph == 2 ? (unsigned)(NATT + tri) : (unsigned)(2 * tri + ph);
#if defined(DUP_P2_MODE)
            if (rep == 0 && REPS(2) == 2 && ((DUP_P2_MODE == 1 && u >= (unsigned)NATT) || (DUP_P2_MODE == 2 && u < (unsigned)NATT))) continue;
#endif
            if (u < (unsigned)NATT) sb_attn_unit(QKU, VT, MIX, (int)u, F.lane);
            else pool_unit(QKU, (const bf16_t*)(ws + WS_WP), args.in[I_POOL_SCALE], MIX, (int)u - NATT, F.lane);
        }
        DUPBAR(2, rep); }
    }
    SEAM(2);
    if (IN(3)) {
        SchedStd S{(const char*)MIX, (const char*)(ws + WS_WOUT), nullptr, F.G, (int)blockIdx.x};
        EpiRes<true> E{(const void*)args.in[I_X], H1, (float*)(ws + WS_SS1)};
        _Pragma("unroll") for (int rep = 0; rep < REPS(3); ++rep) { pg8::gemm_phase<EpiRes<true>, SchedStd, false, true>(F.lds, D, D, D, S, E); DUPBAR(3, rep); }
    }
    SEAM(3);
    if (IN(4)) {
        SchedStd S{(const char*)H1, (const char*)(ws + WS_WQ), QM, F.G, (int)blockIdx.x};
        EpiStore E{(const float*)(ws + WS_SS1), QSCALE_MEM};
        _Pragma("unroll") for (int rep = 0; rep < REPS(4); ++rep) { pg8::gemm_phase<EpiStore, SchedStd, false, true>(F.lds, D, D, D, S, E); DUPBAR(4, rep); }
    }
    SEAM(4);
    if (IN(5)) {
        _Pragma("unroll") for (int rep = 0; rep < REPS(5); ++rep) { cross_phase(F.lds, QM, (const bf16_t*)(ws + WS_KMEM), (const bf16_t*)(ws + WS_VMT), OC, F.vcu, F.G, F.wave, F.lane); DUPBAR(5, rep); }
    }
    SEAM(5);
    if (IN(6)) {
        SchedStd S{(const char*)OC, (const char*)(ws + WS_WO), nullptr, F.G, (int)blockIdx.x};
        EpiRes<false> E{(const void*)H1, H2, (float*)(ws + WS_SS2)};
        _Pragma("unroll") for (int rep = 0; rep < REPS(6); ++rep) { pg8::gemm_phase<EpiRes<false>, SchedStd, false, true>(F.lds, D, D, D, S, E); DUPBAR(6, rep); }
    }
    SEAM(6);
    if (IN(7)) {
        for (int rg = gw; rg < NTOK / 32; rg += NGW) router_unit(H2, (const bf16_t*)(ws + WS_WR), (const float*)(ws + WS_SS2), (f32x4*)(ws + WS_RINFO), F.ctl, rg, F.lane);
    }
    SEAM(7);
    if (IN(8) || IN(9)) {
        __syncthreads();
        int t2 = F.tid; asm volatile("" : "+v"(t2));
        if (t2 < NCOMBO) F.MISC[MW_CNT + t2] = __hip_atomic_load(F.ctl + CW_CNT + 64 * t2, RLX_AGENT);
        __syncthreads();
        if (F.tid == 0) { unsigned acc = 0; for (int k = 0; k < NCOMBO; ++k) { F.MISC[MW_TP + k] = acc; acc += (F.MISC[MW_CNT + k] + 255u) >> 8; } F.MISC[MW_TP + NCOMBO] = acc; }
        __syncthreads();
    }
    if (IN(8)) {
        SchedP8 S{F.MISC, (const char*)H2, (const char*)(ws + WS_GU), (char*)HH, (const f32x4*)(ws + WS_RINFO), F.G, F.vcu};
        EpiGU E{(const f32x4*)(ws + WS_RINFO)};
        _Pragma("unroll") for (int rep = 0; rep < REPS(8); ++rep) { pg8::gemm_phase<EpiGU, SchedP8, true, true>(F.lds, D, D, D, S, E); DUPBAR(8, rep); }
    }
    SEAM(8);
    if (IN(9)) {
        SchedP9 S{F.MISC, (const char*)HH, (const char*)(ws + WS_WD), F.G, F.vcu};
        EpiDown E{(const f32x4*)(ws + WS_RINFO), H2, args.out, (float*)(ws + WS_SS3)};
        _Pragma("unroll") for (int rep = 0; rep < REPS(9); ++rep) { pg8::gemm_phase<EpiDown, SchedP9, false, true>(F.lds, D, 512, 512, S, E); DUPBAR(9, rep); }
    }
    SEAM(9);
    if (IN(10)) {
        const float* ss3 = (const float*)(ws + WS_SS3); const f32x4* gf = (const f32x4*)args.in[I_NORM_FINAL] + F.lane;
        _Pragma("unroll") for (int rep = 0; rep < REPS(10); ++rep) {
        const bool real = (rep == REPS(10) - 1);
        for (int m = gw * 2; m < NTOK; m += NGW * 2) {
            f32x4 v[2][4]; float rs[2];
#pragma unroll
            for (int q = 0; q < 2; ++q) { const f32x4* o = (const f32x4*)(args.out + (size_t)(m + q) * D) + F.lane;
#pragma unroll
                for (int j = 0; j < 4; ++j) v[q][j] = o[64 * j]; }
#pragma unroll
            for (int q = 0; q < 2; ++q) { const float t = sum16(ss3, (unsigned)(m + q) * 64u); rs[q] = real ? 1.0f / sqrtf(t * (1.f / D) + RMS_EPS) : 1.f; }
#pragma unroll
            for (int q = 0; q < 2; ++q) { f32x4* o = (f32x4*)(args.out + (size_t)(m + q) * D) + F.lane;
#pragma unroll
                for (int j = 0; j < 4; ++j) { f32x4 g = gf[64 * j]; if (!real) g = (f32x4){1.f, 1.f, 1.f, 1.f}; f32x4 x = v[q][j]; x.x *= rs[q] * g.x; x.y *= rs[q] * g.y; x.z *= rs[q] * g.z; x.w *= rs[q] * g.w; o[64 * j] = x; } }
        }
        DUPBAR(10, rep); }
    }
#undef IN
#undef SEAM
}

extern "C" void kernel_launch(void* const* d_in, const int* in_sizes, int n_in, void* d_out, int out_size, void* d_ws, size_t ws_size, hipStream_t stream) {
    static int grid = 0;
    if (grid == 0) {
        if (n_in != 20 || in_sizes[0] != NTOK * D || out_size != NTOK * D || ws_size < WS_END) { fprintf(stderr, "kernel_launch: unexpected shapes (n_in %d, in0 %d, out %d, ws %zu); nothing launched\n", n_in, n_in > 0 ? in_sizes[0] : -1, out_size, ws_size); grid = -1; return; }
        int dev = 0, cus = 0, per_cu = 0;
        if (hipGetDevice(&dev) != hipSuccess || hipDeviceGetAttribute(&cus, hipDeviceAttributeMultiprocessorCount, dev) != hipSuccess) { grid = -1; return; }
        if (hipFuncSetAttribute((const void*)fwd, hipFuncAttributeMaxDynamicSharedMemorySize, LDS_BYTES) != hipSuccess) { fprintf(stderr, "kernel_launch: hipFuncSetAttribute failed\n"); grid = -1; return; }
        if (hipOccupancyMaxActiveBlocksPerMultiprocessor(&per_cu, (const void*)fwd, NWAVES * 64, LDS_BYTES) != hipSuccess || per_cu < 1) { fprintf(stderr, "kernel_launch: occupancy query reports %d blocks per CU\n", per_cu); }
        (void)hipGetLastError();
        grid = cus;
    }
    if (grid < 0) return;
    if (hipMemsetAsync((char*)d_ws + WS_CTL, 0, CTL_ZERO_BYTES, stream) != hipSuccess) return;
    Args a{};
    for (int i = 0; i < 20; ++i) a.in[i] = (const float*)d_in[i];
    a.out = (float*)d_out; a.ws = (unsigned char*)d_ws;
    if (MK_N_LAUNCHES == 1) { a.ph_lo = 0; a.ph_hi = N_PHASES; hipLaunchKernelGGL(fwd, dim3(grid), dim3(NWAVES * 64), LDS_BYTES, stream, a); }
    else { for (int p = 0; p < N_PHASES; ++p) { a.ph_lo = p; a.ph_hi = p + 1; hipLaunchKernelGGL(fwd, dim3(grid), dim3(NWAVES * 64), LDS_BYTES, stream, a); } }
}
```

```cpp
#include <hip/hip_runtime.h>
#include <cstdio>
#include <cstdint>

#ifndef MK_N_LAUNCHES
#define MK_N_LAUNCHES 1
#endif

#define LAS __attribute__((address_space(3)))
#define GAS __attribute__((address_space(1)))
typedef unsigned short bf16_t;
typedef short bf16x8 __attribute__((ext_vector_type(8)));
typedef float f32x2 __attribute__((ext_vector_type(2)));
typedef float f32x4 __attribute__((ext_vector_type(4)));
typedef float f32x16 __attribute__((ext_vector_type(16)));
typedef unsigned u32x2 __attribute__((ext_vector_type(2)));
typedef unsigned u32x4 __attribute__((ext_vector_type(4)));
typedef __bf16 bf16x2_t __attribute__((ext_vector_type(2)));
typedef GAS unsigned gu32;

constexpr int NTOK = 32768, SEQ = 8192, NB = 4, D = 1024;
constexpr int INW = 2048;
constexpr int QKU_LD = 1536;
constexpr int MEMROWS = 1024;
constexpr int NCOMBO = 24;
constexpr float RMS_EPS = 1e-6f;
constexpr float LOG2E = 1.4426950408889634f;
constexpr float QSCALE_SB = 0.125f * LOG2E;
constexpr float QSCALE_MEM = 0.0625f * LOG2E;

constexpr size_t MiB = 1u << 20;
constexpr size_t WS_CTL = 0, CTL_ZERO_BYTES = 1 * MiB;
constexpr size_t WS_WIN = 2 * MiB;
constexpr size_t WS_WOUT = 6 * MiB;
constexpr size_t WS_WQ = 8 * MiB;
constexpr size_t WS_WKV = 10 * MiB;
constexpr size_t WS_WO = 14 * MiB;
constexpr size_t WS_GU = 16 * MiB;
constexpr size_t WS_WD = 48 * MiB;
constexpr size_t WS_WP = 64 * MiB;
constexpr size_t WS_WR = 64 * MiB + 256 * 1024;
constexpr size_t WS_MEMN = 65 * MiB;
constexpr size_t WS_KMEM = 67 * MiB;
constexpr size_t WS_VMT = 69 * MiB;
constexpr size_t WS_SS1 = 72 * MiB;
constexpr size_t WS_SS2 = 74 * MiB;
constexpr size_t WS_SS3 = 76 * MiB;
constexpr size_t WS_RINFO = 80 * MiB;
constexpr size_t WS_RA = 96 * MiB;
constexpr size_t WS_RB = 160 * MiB;
constexpr size_t WS_H3 = 288 * MiB;
constexpr size_t WS_END = 352 * MiB;
constexpr size_t WS_VT = WS_RB + 96 * MiB;
constexpr size_t WS_OC = WS_RB + 64 * MiB;
constexpr int CW_TMO = 0;
constexpr int CW_QUEUE = 1024;
constexpr int CW_CNT = 2048;
constexpr int CW_BAR = 4096;

constexpr int RING_BYTES = 131072;
constexpr int LDSCTL_OFF = 139264;
constexpr int LDS_BYTES = 147456;
constexpr int MW_BAR = 8, MW_CUR = 12, MW_CNT = 16, MW_TP = 40;
#ifndef P2_SLOTS_GEMM
#define P2_SLOTS_GEMM 20
#define P2_SLOTS_OTHER 52
#endif

constexpr int NWAVES = 8;

#define LDS_WAIT() asm volatile("s_waitcnt lgkmcnt(0)" ::: "memory")
#define VM_WAIT() asm volatile("s_waitcnt vmcnt(0)" ::: "memory")
#define RLX_AGENT __ATOMIC_RELAXED, __HIP_MEMORY_SCOPE_AGENT

__device__ __forceinline__ unsigned f2bf(float f) { unsigned u = __builtin_bit_cast(unsigned, f); return (u + 0x7fffu + ((u >> 16) & 1u)) >> 16; }
__device__ __forceinline__ unsigned pk2(float lo, float hi) { return f2bf(lo) | (f2bf(hi) << 16); }
__device__ __forceinline__ unsigned cvtpk(float lo, float hi) { f32x2 v = {lo, hi}; bf16x2_t b = __builtin_convertvector(v, bf16x2_t); return __builtin_bit_cast(unsigned, b); }
__device__ __forceinline__ float bflo(unsigned w) { return __builtin_bit_cast(float, w << 16); }
__device__ __forceinline__ float bfhi(unsigned w) { return __builtin_bit_cast(float, w & 0xffff0000u); }
__device__ __forceinline__ float wave_sum(float v) {
#pragma unroll
    for (int o = 1; o < 64; o <<= 1) v += __shfl_xor(v, o);
    return v;
}
#define MFMA32(a, b, c) __builtin_amdgcn_mfma_f32_32x32x16_bf16((a), (b), (c), 0, 0, 0)

namespace pg8 {
constexpr int BM = 256, BK = 64, HALF = 128, HTB = HALF * BK * 2, STAGE_BYTES = 8 * HTB, NXCD = 8, WGM = 8;
__host__ __device__ __forceinline__ int lds_byte(int r, int c) { const int st = (r >> 4) * 2 + (c >> 5), rr = r & 15, cc = c & 31, ob = rr * 64 + cc * 2; return st * 1024 + (ob ^ (((ob >> 9) & 1) << 5)); }
__host__ __device__ __forceinline__ void stage_rc(int b, int& R, int& C) { const int st = b / 1024, sb = b % 1024, swz = sb ^ (((sb >> 9) & 1) << 5); R = (st >> 1) * 16 + swz / 64; C = (st & 1) * 32 + (swz % 64) / 2; }
__host__ __device__ __forceinline__ int perm32(int rho) { const int n = rho >> 4, i = rho & 15; return 8 * (i >> 2) + 4 * n + (i & 3); }

struct Unit { const char* A; const char* B; char* O; int ldc; float scale; int pm, pn, flags, aux0, aux1, aux2; };

__device__ __forceinline__ void map_std(int nM, int nN, int L, int& pm, int& pn) {
    const int nwg = nM * nN; int wgid = L; { const int q = nwg / NXCD, r = nwg % NXCD, xcd = wgid % NXCD, off = wgid / NXCD; wgid = (xcd < r ? xcd * (q + 1) : r * (q + 1) + (xcd - r) * q) + off; }
    const int nig = WGM * nN, gid = wgid / nig, fm = gid * WGM, gsz = (nM - fm) < WGM ? (nM - fm) : WGM;
    pm = fm + ((wgid % nig) % gsz); pn = (wgid % nig) / gsz;
}

template <class Epi, class Sched, bool GATHER, bool ALIGN_EPI>
__device__ __forceinline__ void gemm_phase(LAS unsigned char* lds, const int lda, const int ldb, const int K, const Sched& S, const Epi& E) {
    const int tid = threadIdx.x, wid = __builtin_amdgcn_readfirstlane(tid >> 6), lane = tid & 63, wr = wid >> 2, wc = wid & 3, fr = lane & 15, fq = lane >> 4;
    const int nt = K / BK;
    int R0, C0; stage_rc(tid * 16, R0, C0);
    const int R1 = R0 + 64;
    const int Rb0 = (R0 & ~31) + perm32(R0 & 31), Rb1 = (R1 & ~31) + perm32(R1 & 31);
    unsigned voffB[2]; voffB[0] = (unsigned)(Rb0 * ldb + C0) * 2u; voffB[1] = (unsigned)(Rb1 * ldb + C0) * 2u;
    unsigned cvA[2][2];
    const size_t kstep = (size_t)(BK * 2);
    const size_t hstepB = (size_t)HALF * ldb * 2;
    const unsigned ldsw = (unsigned)wid * 1024u;
    const int aoff = lds_byte(wr * 64 + fr, fq * 8), boff = lds_byte(wc * 32 + fr, fq * 8);
#define PG8_SA(b, h) (((b) * 2 + (h)) * HTB)
#define PG8_SB(b, h) ((4 + (b) * 2 + (h)) * HTB)
#define PG8_STAGE(bufoff, gbase, voff) do { _Pragma("unroll") for (int _i = 0; _i < 2; ++_i) \
        __builtin_amdgcn_global_load_lds((const unsigned*)((const char*)(gbase) + (voff)[_i]), (LAS unsigned*)(lds + (bufoff) + ldsw + _i * 8192), 16, 0, 0); } while (0)
#define PG8_LDA(dst, b, h) do { _Pragma("unroll") for (int m = 0; m < 4; ++m) _Pragma("unroll") for (int k = 0; k < 2; ++k) dst[m][k] = *(const LAS bf16x8*)(lds + PG8_SA(b, h) + aoff + m * 2048 + k * 1024); } while (0)
#define PG8_LDB(dst, b, h) do { _Pragma("unroll") for (int n = 0; n < 2; ++n) _Pragma("unroll") for (int k = 0; k < 2; ++k) dst[n][k] = *(const LAS bf16x8*)(lds + PG8_SB(b, h) + boff + n * 2048 + k * 1024); } while (0)
#define PG8_MMA(ai, bj, At, Bt) do { __builtin_amdgcn_s_setprio(1); _Pragma("unroll") for (int m = 0; m < 4; ++m) _Pragma("unroll") for (int n = 0; n < 2; ++n) _Pragma("unroll") for (int k = 0; k < 2; ++k) \
        acc[ai][bj][m][n] = __builtin_amdgcn_mfma_f32_16x16x32_bf16(Bt[n][k], At[m][k], acc[ai][bj][m][n], 0, 0, 0); __builtin_amdgcn_s_setprio(0); } while (0)
#define PG8_WAIT_V(n) asm volatile("s_waitcnt vmcnt(" #n ")" ::: "memory")
#define PG8_WAIT_L(n) asm volatile("s_waitcnt lgkmcnt(" #n ")" ::: "memory")
#define PG8_BAR __builtin_amdgcn_s_barrier()
#define PG8_SCHED __builtin_amdgcn_sched_barrier(0)
#define PG8_TABLD(u, buf) do { if (wid < 4) { __builtin_amdgcn_global_load_lds(S.tokptr(u, wid * 64 + lane), (LAS unsigned*)(tokTab + (buf) * 256 + wid * 64), 4, 0, 0); } } while (0)
#define PG8_ROWOFF_G(dst, buf) do { const LAS int* _t = tokTab + (buf) * 256; \
        dst[0][0] = (unsigned)(_t[R0] * lda + C0) * 2u; dst[0][1] = (unsigned)(_t[R1] * lda + C0) * 2u; dst[1][0] = (unsigned)(_t[HALF + R0] * lda + C0) * 2u; dst[1][1] = (unsigned)(_t[HALF + R1] * lda + C0) * 2u; } while (0)
    LAS int* const tokTab = (LAS int*)(lds + 139264 + 1024);
    Unit cur, nxt; int ui = 0;
    if (!S.next(0, cur)) return;
    f32x4 acc[2][2][4][2];
#pragma unroll
    for (int a = 0; a < 2; ++a)
#pragma unroll
        for (int b = 0; b < 2; ++b)
#pragma unroll
            for (int m = 0; m < 4; ++m)
#pragma unroll
                for (int n = 0; n < 2; ++n) acc[a][b][m][n] = (f32x4){0.f, 0.f, 0.f, 0.f};
    bf16x8 At[4][2], B0[2][2], B1[2][2];
    if constexpr (GATHER) { PG8_TABLD(cur, 0); PG8_WAIT_V(0); __syncthreads(); PG8_ROWOFF_G(cvA, 0); }
    else { cvA[0][0] = (unsigned)(R0 * lda + C0) * 2u; cvA[0][1] = (unsigned)(R1 * lda + C0) * 2u; cvA[1][0] = (unsigned)((HALF + R0) * lda + C0) * 2u; cvA[1][1] = (unsigned)((HALF + R1) * lda + C0) * 2u; }
    const char* cA = cur.A; const char* cB = cur.B;
    PG8_STAGE(PG8_SB(0, 0), cB, voffB); PG8_STAGE(PG8_SB(0, 1), cB + hstepB, voffB); PG8_STAGE(PG8_SA(0, 0), cA, cvA[0]); PG8_STAGE(PG8_SA(0, 1), cA, cvA[1]);
    if (wr == 1) PG8_BAR;
    PG8_WAIT_V(2); PG8_BAR;
    PG8_STAGE(PG8_SB(1, 0), cB + kstep, voffB); PG8_STAGE(PG8_SA(1, 0), cA + kstep, cvA[0]); PG8_STAGE(PG8_SB(1, 1), cB + hstepB + kstep, voffB);
    PG8_WAIT_V(6); PG8_BAR;
    for (;;) {
        const bool has_next = S.next(ui + 1, nxt);
        const char* nA = has_next ? nxt.A : cA; const char* nB = has_next ? nxt.B : cB;
        if constexpr (GATHER) { if (has_next) PG8_TABLD(nxt, (ui + 1) & 1); }
        for (int t = 0; t < nt; t += 2) {
            const bool last = (t == nt - 2);
            const char* a1 = cA + (size_t)(t + 1) * kstep;
            const char* a2 = last ? nA : cA + (size_t)(t + 2) * kstep; const char* b2 = last ? nB : cB + (size_t)(t + 2) * kstep;
            const char* a3 = a2 + kstep; const char* b3 = b2 + kstep;
            unsigned o2[2][2];
            o2[0][0] = cvA[0][0]; o2[0][1] = cvA[0][1]; o2[1][0] = cvA[1][0]; o2[1][1] = cvA[1][1];
            if constexpr (GATHER) { if (last && has_next) { PG8_ROWOFF_G(o2, (ui + 1) & 1); } }
            PG8_LDB(B0, 0, 0); PG8_LDB(B1, 0, 1); PG8_SCHED; PG8_LDA(At, 0, 0); PG8_STAGE(PG8_SA(1, 1), a1, cvA[1]);
            PG8_WAIT_V(8); PG8_WAIT_L(0); PG8_BAR; PG8_MMA(0, 0, At, B0); PG8_MMA(0, 1, At, B1); PG8_BAR; PG8_SCHED;
            PG8_LDA(At, 0, 1); PG8_STAGE(PG8_SB(0, 0), b2, voffB); PG8_STAGE(PG8_SB(0, 1), b2 + hstepB, voffB); PG8_STAGE(PG8_SA(0, 0), a2, o2[0]);
            PG8_WAIT_V(8); PG8_WAIT_L(0); PG8_BAR; PG8_MMA(1, 0, At, B0); PG8_MMA(1, 1, At, B1); PG8_BAR; PG8_SCHED;
            PG8_LDB(B0, 1, 0); PG8_LDB(B1, 1, 1); PG8_SCHED; PG8_LDA(At, 1, 0); PG8_STAGE(PG8_SA(0, 1), a2, o2[1]);
            PG8_WAIT_V(8); PG8_WAIT_L(0); PG8_BAR; PG8_MMA(0, 0, At, B0); PG8_MMA(0, 1, At, B1); PG8_BAR; PG8_SCHED;
            PG8_LDA(At, 1, 1); PG8_STAGE(PG8_SB(1, 0), b3, voffB); PG8_STAGE(PG8_SB(1, 1), b3 + hstepB, voffB); PG8_STAGE(PG8_SA(1, 0), a3, o2[0]);
            PG8_WAIT_V(8); PG8_WAIT_L(0); PG8_BAR; PG8_MMA(1, 0, At, B0); PG8_MMA(1, 1, At, B1); PG8_BAR; PG8_SCHED;
        }
        if constexpr (ALIGN_EPI) { if (wr == 0) PG8_BAR; }
        if (cur.flags & 2) E(acc, cur, wr, wc, fr, fq);
        if (!has_next) break;
        if (nxt.flags & 1) {
#pragma unroll
            for (int a = 0; a < 2; ++a)
#pragma unroll
                for (int b = 0; b < 2; ++b)
#pragma unroll
                    for (int m = 0; m < 4; ++m)
#pragma unroll
                        for (int n = 0; n < 2; ++n) acc[a][b][m][n] = (f32x4){0.f, 0.f, 0.f, 0.f};
        }
        cur = nxt; cA = nA; cB = nB; ++ui;
        if constexpr (GATHER) { PG8_ROWOFF_G(cvA, ui & 1); }
        if constexpr (ALIGN_EPI) { if (wr == 1) PG8_BAR; }
    }
    PG8_WAIT_V(0);
    if constexpr (!ALIGN_EPI) { if (wr == 0) PG8_BAR; }
    PG8_BAR;
#undef PG8_SA
#undef PG8_SB
#undef PG8_STAGE
#undef PG8_LDA
#undef PG8_LDB
#undef PG8_MMA
#undef PG8_WAIT_V
#undef PG8_WAIT_L
#undef PG8_BAR
#undef PG8_SCHED
#undef PG8_ROWOFF_G
#undef PG8_TABLD
}
}
using pg8::Unit;

#define XB_TMO      128
#define XB_XCNT(j)  (256  + 64 * (j))
#define XB_XSUB(j)  (1280 + 64 * (j))
#define XB_XGEN(j)  (2304 + 64 * (j))
#define XB_TOP      3328
#define XB_TOPGEN   3392
#define XCD_BAR_WORDS 3456
#define XB_SPIN_CAP (1u << 18)
__device__ __forceinline__ unsigned xb_ld(unsigned* p)              { return __hip_atomic_load(p, __ATOMIC_RELAXED, __HIP_MEMORY_SCOPE_AGENT); }
__device__ __forceinline__ unsigned xb_add(unsigned* p, unsigned v) { return __hip_atomic_fetch_add(p, v, __ATOMIC_RELAXED, __HIP_MEMORY_SCOPE_AGENT); }
__device__ __forceinline__ unsigned xb_xcc_id() { return (unsigned)__builtin_amdgcn_s_getreg((3 << 11) | 20) & 0xFu; }
#define XB_SPIN(cond, bar) do { unsigned _sp = 0; while (cond) { __builtin_amdgcn_s_sleep(1); \
    if ((++_sp & 255u) == 0u) { if (xb_ld(&(bar)[XB_TMO])) break; if (_sp > XB_SPIN_CAP) { atomicAdd(&(bar)[XB_TMO], 1u); break; } } } } while (0)
struct XcdBarrier { unsigned* bar; unsigned x; volatile LAS unsigned* st; };
__device__ __forceinline__ XcdBarrier xcd_barrier_post(unsigned* bar, volatile LAS unsigned* st) {
    XcdBarrier b; b.bar = bar; b.x = xb_xcc_id(); b.st = st;
    if (threadIdx.x == 0) (void)xb_add(&bar[XB_XCNT(b.x)], 1u);
    return b;
}
__device__ __forceinline__ void xcd_barrier_complete(unsigned* bar, unsigned x, unsigned& nloc, unsigned& nx) {
    const unsigned G = gridDim.x * gridDim.y * gridDim.z;
    unsigned sum, cnt, mine, sp = 0u;
    for (;;) {
        sum = 0u; cnt = 0u; mine = 0u;
#pragma unroll
        for (unsigned j = 0; j < 16; ++j) { const unsigned c = xb_ld(&bar[XB_XCNT(j)]); sum += c; cnt += (c > 0u) ? 1u : 0u; mine = (j == x) ? c : mine; }
        if (sum == G) break;
        __builtin_amdgcn_s_sleep(1);
        if ((++sp & 255u) == 0u) { if (xb_ld(&bar[XB_TMO])) break; if (sp > XB_SPIN_CAP) { atomicAdd(&bar[XB_TMO], 1u); break; } }
    }
    nloc = mine > 0u ? mine : 1u; nx = cnt > 0u ? cnt : 1u;
}
__device__ __forceinline__ void xcd_barrier(const XcdBarrier& b) {
    asm volatile("s_waitcnt vmcnt(0)" ::: "memory");
    __syncthreads();
    if (threadIdx.x == 0) {
        unsigned* bar = b.bar;
        __builtin_amdgcn_s_waitcnt(0);
        unsigned nloc = b.st[0], nx = b.st[1];
        if (nloc == 0u) { xcd_barrier_complete(bar, b.x, nloc, nx); b.st[0] = nloc; b.st[1] = nx; }
        const unsigned old = xb_add(&bar[XB_XSUB(b.x)], 1u);
        const unsigned gen = old / nloc;
        if (old + 1u == (gen + 1u) * nloc) {
            __builtin_amdgcn_fence(__ATOMIC_RELEASE, "agent");
            asm volatile("s_waitcnt vmcnt(0)" ::: "memory");
            const unsigned og = xb_add(&bar[XB_TOP], 1u);
            const unsigned tg = og / nx;
            if (og + 1u == (tg + 1u) * nx) xb_add(&bar[XB_TOPGEN], 1u);
            else XB_SPIN(xb_ld(&bar[XB_TOPGEN]) == tg, bar);
            __builtin_amdgcn_fence(__ATOMIC_ACQUIRE, "agent");
            xb_add(&bar[XB_XGEN(b.x)], 1u);
            asm volatile("s_waitcnt vmcnt(0)" ::: "memory");
        } else {
            XB_SPIN(xb_ld(&bar[XB_XGEN(b.x)]) == gen, bar);
            __builtin_amdgcn_fence(__ATOMIC_ACQUIRE, "agent");
            asm volatile("s_waitcnt vmcnt(0)" ::: "memory");
        }
    }
    __syncthreads();
}

struct Frame {
    LAS unsigned char* lds;
    volatile LAS unsigned* MISC;
    unsigned* ctl;
    int tid, lane, wave, vcu, G;
    unsigned char* ws;
};
enum { I_X = 0, I_MEM, I_NORM_MIX, I_W_IN, I_W_POOL, I_POOL_SCALE, I_W_OUT, I_NORM_CROSS, I_NORM_MEM, I_WQ, I_WK, I_WV, I_WO, I_NORM_FFN, I_W_GROUP, I_W_EXPERT, I_W_GATE, I_W_UP, I_W_DOWN, I_NORM_FINAL };

__device__ __forceinline__ void p0_transpose_item(const float* W, int ldw, int k0, int n0, const float* gain, bf16_t* dst, int ldd, LAS float* scr, int lane) {
    f32x4 v[8]; float g[8];
    const int c4 = (lane & 7) * 4, kr = lane >> 3;
#pragma unroll
    for (int i = 0; i < 8; ++i) { v[i] = *(const f32x4*)(W + (size_t)(k0 + kr + 8 * i) * ldw + n0 + c4); g[i] = gain ? gain[k0 + kr + 8 * i] : 1.f; }
#pragma unroll
    for (int i = 0; i < 8; ++i) { LAS float* p = scr + (kr + 8 * i) * 33 + c4; p[0] = v[i].x * g[i]; p[1] = v[i].y * g[i]; p[2] = v[i].z * g[i]; p[3] = v[i].w * g[i]; }
    LDS_WAIT(); asm volatile("" ::: "memory");
    const int c = lane & 7;
#pragma unroll
    for (int j = 0; j < 4; ++j) { const int n = (lane >> 3) + 8 * j; const LAS float* s = scr + (8 * c) * 33 + n;
        u32x4 o; o.x = pk2(s[0 * 33], s[1 * 33]); o.y = pk2(s[2 * 33], s[3 * 33]); o.z = pk2(s[4 * 33], s[5 * 33]); o.w = pk2(s[6 * 33], s[7 * 33]);
        *(u32x4*)(dst + (size_t)n * ldd + 8 * c) = o; }
    LDS_WAIT(); asm volatile("" ::: "memory");
}
__device__ __forceinline__ void rms_rows4_to_bf16(const float* xrow, const float* gain, bf16_t* orow, int lane) {
    f32x4 v[4][4]; float s[4];
#pragma unroll
    for (int q = 0; q < 4; ++q)
#pragma unroll
        for (int j = 0; j < 4; ++j) v[q][j] = ((const f32x4*)(xrow + (size_t)q * D) + lane)[64 * j];
    const f32x4* gr = (const f32x4*)gain + lane; f32x4 g[4];
#pragma unroll
    for (int j = 0; j < 4; ++j) g[j] = gr[64 * j];
#pragma unroll
    for (int q = 0; q < 4; ++q) { float t = 0.f;
#pragma unroll
        for (int j = 0; j < 4; ++j) t += (v[q][j].x * v[q][j].x + v[q][j].y * v[q][j].y) + (v[q][j].z * v[q][j].z + v[q][j].w * v[q][j].w);
        s[q] = 1.0f / sqrtf(wave_sum(t) * (1.f / D) + RMS_EPS); }
#pragma unroll
    for (int q = 0; q < 4; ++q) { u32x2* o8 = (u32x2*)(orow + (size_t)q * D) + lane; const float r = s[q];
#pragma unroll
        for (int j = 0; j < 4; ++j) { u32x2 w; w.x = pk2(v[q][j].x * r * g[j].x, v[q][j].y * r * g[j].y); w.y = pk2(v[q][j].z * r * g[j].z, v[q][j].w * r * g[j].w); o8[64 * j] = w; } }
}
__device__ __forceinline__ void p0_prologue(Frame& F, const float* const* in) {
    LAS float* scr = (LAS float*)(F.lds + F.wave * 16384);
    const int gw = F.vcu * NWAVES + F.wave, NGW = F.G * NWAVES;
    unsigned char* ws = F.ws;
    constexpr int I_IN = 16 * 64, I_SQ = 16 * 32, I_POOL = 4 * 2 * 4, I_GATE = 16 * 16 * 16, I_DOWN = 16 * 8 * 32;
    constexpr int NITEMS = I_IN + 5 * I_SQ + I_POOL + 2 * I_GATE + I_DOWN;
    for (int it = gw; it < NITEMS; it += NGW) {
        int r = it, src, gsrc = -1, ldw, k0, n0, ldd; size_t soff = 0, doff;
        if (r < I_IN) { const int kb = r / 64, nb = r % 64; src = I_W_IN; ldw = INW; k0 = 64 * kb; n0 = 32 * nb; ldd = D; doff = WS_WIN + ((size_t)n0 * D + k0) * 2; }
        else if ((r -= I_IN) < 5 * I_SQ) { const int which = r / I_SQ, q = r % I_SQ, kb = q / 32, nb = q % 32; ldw = D; k0 = 64 * kb; n0 = 32 * nb; ldd = D;
            src = which == 0 ? I_W_OUT : which == 1 ? I_WQ : which == 2 ? I_WK : which == 3 ? I_WV : I_WO; if (which == 1) gsrc = I_NORM_CROSS;
            const size_t base = which == 0 ? WS_WOUT : which == 1 ? WS_WQ : which == 2 ? WS_WKV : which == 3 ? WS_WKV + (size_t)1024 * D * 2 : WS_WO;
            doff = base + ((size_t)n0 * D + k0) * 2; }
        else if ((r -= 5 * I_SQ) < I_POOL) { const int g = r / 8, q = r % 8, kb = q / 4, nb = q % 4; src = I_W_POOL; soff = (size_t)g * 128 * 128; ldw = 128; k0 = 64 * kb; n0 = 32 * nb; ldd = 128;
            doff = WS_WP + ((size_t)g * 128 * 128 + (size_t)n0 * 128 + k0) * 2; }
        else if ((r -= I_POOL) < 2 * I_GATE) { const int up = r / I_GATE, q = r % I_GATE, e = q / 256, q2 = q % 256, kb = q2 / 16, nb = q2 % 16; src = up ? I_W_UP : I_W_GATE; gsrc = I_NORM_FFN;
            soff = (size_t)e * D * 512; ldw = 512; k0 = 64 * kb; n0 = 32 * nb; ldd = D; const int drow = (n0 >> 7) * 256 + up * 128 + (n0 & 127);
            doff = WS_GU + (((size_t)e * 1024 + drow) * D + k0) * 2; }
        else { r -= 2 * I_GATE; const int e = r / 256, q2 = r % 256, kb = q2 / 32, nb = q2 % 32; src = I_W_DOWN; soff = (size_t)e * 512 * D; ldw = D; k0 = 64 * kb; n0 = 32 * nb; ldd = 512;
            doff = WS_WD + (((size_t)e * 1024 + n0) * 512 + k0) * 2; }
        const float* W = in[src] + soff; const float* gain = gsrc >= 0 ? in[gsrc] : nullptr;
        p0_transpose_item(W, ldw, k0, n0, gain, (bf16_t*)(ws + doff), ldd, scr, F.lane);
    }
    {
        bf16_t* wr = (bf16_t*)(ws + WS_WR); const int gt = F.vcu * 512 + F.tid, NT = F.G * 512;
        for (int idx = gt; idx < 32 * D; idx += NT) { const int m = idx >> 10, k = idx & 1023; float v = 0.f;
            if (m < 4) v = in[I_W_GROUP][k * 4 + m] * in[I_NORM_FFN][k]; else if (m >= 8 && m < 24) v = in[I_W_EXPERT][k * 16 + (m - 8)] * in[I_NORM_FFN][k];
            const unsigned h = f2bf(v); const float hf = __builtin_bit_cast(float, h << 16); const unsigned l = f2bf(v - hf);
            wr[idx] = (bf16_t)h; wr[32 * D + idx] = (bf16_t)l; }
    }
    for (int m = gw * 4; m < NTOK; m += NGW * 4) rms_rows4_to_bf16(in[I_X] + (size_t)m * D, in[I_NORM_MIX], (bf16_t*)(ws + WS_RA) + (size_t)m * D, F.lane);
    for (int m = gw * 4; m < MEMROWS; m += NGW * 4) rms_rows4_to_bf16(in[I_MEM] + (size_t)m * D, in[I_NORM_MEM], (bf16_t*)(ws + WS_MEMN) + (size_t)m * D, F.lane);
}

struct SchedP1 {
    const char* XN; const char* WIN; char* QKU; char* VT; int G, c;
    __device__ __forceinline__ bool next(int i, Unit& u) const {
        const int L = i * G + c; if (L >= 1024) return false;
        u.flags = 3; u.aux0 = 0; u.aux1 = 0; u.aux2 = 0;
        if (L < 768) { int pm, pn; pg8::map_std(128, 6, L, pm, pn); u.pm = pm; u.pn = pn;
            u.A = XN + (size_t)pm * 256 * D * 2; u.B = WIN + (size_t)pn * 256 * D * 2; u.O = QKU + ((size_t)pm * 256 * QKU_LD + pn * 256) * 2; u.ldc = QKU_LD; u.scale = (pn == 2 || pn == 3) ? QSCALE_SB : 1.f; }
        else { const int l2 = L - 768, pm = l2 >> 7, pn = l2 & 127; u.pm = pm; u.pn = pn;
            u.A = WIN + (size_t)(1536 + pm * 256) * D * 2; u.B = XN + (size_t)pn * 256 * D * 2; u.O = VT + ((size_t)pm * 256 * NTOK + pn * 256) * 2; u.ldc = NTOK; u.scale = 1.f; }
        return true;
    }
};
struct SchedMemKV {
    const char* MEMN; const char* WKV; char* KMEM; char* VMT; int G, c;
    __device__ __forceinline__ bool next(int i, Unit& u) const {
        const int L = i * G + c; if (L >= 32) return false;
        u.flags = 3; u.aux0 = 0; u.aux1 = 0; u.aux2 = 0; u.ldc = 1024; u.scale = 1.f;
        const int l2 = L & 15, pm = l2 >> 2, pn = l2 & 3; u.pm = pm; u.pn = pn;
        if (L < 16) { u.A = MEMN + (size_t)pm * 256 * D * 2; u.B = WKV + (size_t)pn * 256 * D * 2; u.O = KMEM + ((size_t)pm * 256 * 1024 + pn * 256) * 2; }
        else { u.A = WKV + (size_t)(1024 + pm * 256) * D * 2; u.B = MEMN + (size_t)pn * 256 * D * 2; u.O = VMT + ((size_t)pm * 256 * 1024 + pn * 256) * 2; }
        return true;
    }
};
struct SchedStd {
    const char* A; const char* B; bf16_t* Obase; int G, c;
    __device__ __forceinline__ bool next(int i, Unit& u) const {
        const int L = i * G + c; if (L >= 512) return false;
        int pm, pn; pg8::map_std(128, 4, L, pm, pn); u.pm = pm; u.pn = pn; u.flags = 3; u.aux0 = 0; u.aux1 = 0; u.aux2 = 0; u.O = Obase ? (char*)(Obase + (size_t)pm * 256 * D + pn * 256) : nullptr; u.ldc = D; u.scale = 1.f;
        u.A = A + (size_t)pm * 256 * D * 2; u.B = B + (size_t)pn * 256 * D * 2; return true;
    }
};
__device__ __forceinline__ void moe_decode_tile(volatile LAS unsigned* MISC, int tile, int& c, int& lt, int& nvalid) {
    c = 0;
#pragma unroll 1
    for (int k = 1; k < NCOMBO; ++k) if ((int)MISC[MW_TP + k] <= tile) c = k;
    lt = tile - (int)MISC[MW_TP + c]; const int rem = (int)MISC[MW_CNT + c] - lt * 256; nvalid = rem < 256 ? rem : 256;
}
__device__ __forceinline__ int pair_lo(int p) { return p < 3 ? 0 : (p < 5 ? 1 : 2); }
__device__ __forceinline__ int pair_hi(int p) { return p < 3 ? p + 1 : (p < 5 ? p - 1 : 3); }
struct SchedP8 {
    volatile LAS unsigned* MISC; const char* H2; const char* GU; char* HH; const f32x4* RINFO; int G, c;
    __device__ __forceinline__ bool next(int i, Unit& u) const {
        const int L = i * G + c, T = (int)MISC[MW_TP + NCOMBO]; if (L >= T * 8) return false;
        const int tile = L >> 3, pn = L & 7; int cb, lt, nv; moe_decode_tile(MISC, tile, cb, lt, nv);
        const int g = cb / 6, p = cb % 6, s = pn >> 2, ch = pn & 3, e = 4 * g + (s ? pair_hi(p) : pair_lo(p));
        u.A = H2; u.B = GU + ((size_t)e * 1024 + ch * 256) * D * 2; u.O = HH + ((size_t)tile * 256 * D + s * 512 + ch * 128) * 2; u.ldc = D; u.scale = 1.f;
        u.pm = tile; u.pn = pn; u.flags = 3; u.aux0 = cb * NTOK + lt * 256; u.aux1 = nv; u.aux2 = s; return true;
    }
    __device__ __forceinline__ const unsigned* tokptr(const Unit& u, int r) const { const int rr = r < u.aux1 ? r : u.aux1 - 1; return (const unsigned*)(RINFO + (u.aux0 + rr)) + 3; }
};
struct SchedP9 {
    volatile LAS unsigned* MISC; const char* HH; const char* WD; int G, c;
    __device__ __forceinline__ bool next(int i, Unit& u) const {
        const int L = (i >> 1) * G + c, ks = i & 1, T = (int)MISC[MW_TP + NCOMBO]; if (L >= T * 4) return false;
        const int tile = L >> 2, pn = L & 3; int cb, lt, nv; moe_decode_tile(MISC, tile, cb, lt, nv);
        const int g = cb / 6, p = cb % 6, e = 4 * g + (ks ? pair_hi(p) : pair_lo(p));
        u.A = HH + ((size_t)tile * 256 * D + ks * 512) * 2; u.B = WD + ((size_t)e * 1024 + pn * 256) * 512 * 2; u.O = nullptr; u.ldc = D; u.scale = 1.f;
        u.pm = tile; u.pn = pn; u.flags = ks ? 2 : 1; u.aux0 = cb * NTOK + lt * 256; u.aux1 = nv; u.aux2 = ks; return true;
    }
};

__device__ __forceinline__ u32x4 ldg16(const void* base, unsigned off) { return *(const u32x4*)((const char*)base + off); }
__device__ __forceinline__ f32x4 ldg16f(const void* base, unsigned off) { return *(const f32x4*)((const char*)base + off); }
__device__ __forceinline__ void stg16(void* base, unsigned off, u32x4 v) { *(u32x4*)((char*)base + off) = v; }
__device__ __forceinline__ void stg16f(void* base, unsigned off, f32x4 v) { *(f32x4*)((char*)base + off) = v; }
__device__ __forceinline__ float sum16(const void* base, unsigned off) {
    const f32x4 a = ldg16f(base, off), b = ldg16f(base, off + 16), c = ldg16f(base, off + 32), d = ldg16f(base, off + 48);
    return ((a.x + a.y) + (a.z + a.w)) + ((b.x + b.y) + (b.z + b.w)) + ((c.x + c.y) + (c.z + c.w)) + ((d.x + d.y) + (d.z + d.w));
}
__device__ __forceinline__ u32x4 pack8(const f32x4 v0, const f32x4 v1) { u32x4 w; w.x = cvtpk(v0[0], v0[1]); w.y = cvtpk(v0[2], v0[3]); w.z = cvtpk(v1[0], v1[1]); w.w = cvtpk(v1[2], v1[3]); return w; }
__device__ __forceinline__ float sq8(const f32x4 v0, const f32x4 v1) { return (v0[0] * v0[0] + v0[1] * v0[1]) + (v0[2] * v0[2] + v0[3] * v0[3]) + (v1[0] * v1[0] + v1[1] * v1[1]) + (v1[2] * v1[2] + v1[3] * v1[3]); }
struct EpiStore {
    const float* ss; float rowmul;
    __device__ __forceinline__ void operator()(const f32x4 (&acc)[2][2][4][2], const Unit& u, int wr, int wc, int fr, int fq) const {
        const unsigned lcol = (unsigned)(wc * 32 + 8 * fq) * 2u;
#pragma unroll
        for (int ai = 0; ai < 2; ++ai)
#pragma unroll
            for (int m = 0; m < 4; ++m) { const int r = ai * 128 + wr * 64 + m * 16 + fr; float sc = u.scale;
                if (ss) { const float t = sum16(ss, (unsigned)(u.pm * 256 + r) * 64u); sc = rowmul / sqrtf(t * (1.f / D) + RMS_EPS); }
                const unsigned ro = (unsigned)(r * u.ldc) * 2u + lcol;
#pragma unroll
                for (int bj = 0; bj < 2; ++bj) stg16(u.O, ro + bj * 256, pack8(acc[ai][bj][m][0] * sc, acc[ai][bj][m][1] * sc)); }
    }
};
template <bool RESF32> struct EpiRes {
    const void* res; bf16_t* out; float* ss;
    __device__ __forceinline__ void operator()(const f32x4 (&acc)[2][2][4][2], const Unit& u, int wr, int wc, int fr, int fq) const {
        const int col0 = u.pn * 256 + wc * 32 + 8 * fq;
#pragma unroll
        for (int ai = 0; ai < 2; ++ai)
#pragma unroll
            for (int m = 0; m < 4; ++m) { const int grow = u.pm * 256 + ai * 128 + wr * 64 + m * 16 + fr; float sq = 0.f;
#pragma unroll
                for (int bj = 0; bj < 2; ++bj) { const unsigned eoff = (unsigned)(grow * D + col0 + bj * 128); f32x4 r0, r1;
                    if constexpr (RESF32) { r0 = ldg16f(res, eoff * 4u); r1 = ldg16f(res, eoff * 4u + 16u); }
                    else { const u32x4 w = ldg16(res, eoff * 2u); r0 = (f32x4){bflo(w.x), bfhi(w.x), bflo(w.y), bfhi(w.y)}; r1 = (f32x4){bflo(w.z), bfhi(w.z), bflo(w.w), bfhi(w.w)}; }
                    const f32x4 v0 = acc[ai][bj][m][0] + r0, v1 = acc[ai][bj][m][1] + r1;
                    sq += sq8(v0, v1);
                    stg16(out, eoff * 2u, pack8(v0, v1)); }
                sq += __shfl_xor(sq, 16); sq += __shfl_xor(sq, 32);
                if (fq == 0) *(float*)((char*)ss + (unsigned)(grow * 16 + u.pn * 4 + wc) * 4u) = sq; }
    }
};
struct EpiGU {
    const f32x4* rinfo;
    __device__ __forceinline__ void operator()(const f32x4 (&acc)[2][2][4][2], const Unit& u, int wr, int wc, int fr, int fq) const {
        const unsigned lcol = (unsigned)(wc * 32 + 8 * fq) * 2u;
#pragma unroll
        for (int ai = 0; ai < 2; ++ai)
#pragma unroll
            for (int m = 0; m < 4; ++m) { const int r = ai * 128 + wr * 64 + m * 16 + fr; const int rr = r < u.aux1 ? r : u.aux1 - 1;
                const f32x4 info = ldg16f(rinfo, (unsigned)(u.aux0 + rr) * 16u); const float rs = info.x, wgt = u.aux2 ? info.z : info.y;
                f32x4 h0, h1;
#pragma unroll
                for (int j = 0; j < 4; ++j) { const float g0 = acc[ai][0][m][0][j] * rs, u0 = acc[ai][1][m][0][j] * rs, g1 = acc[ai][0][m][1][j] * rs, u1 = acc[ai][1][m][1][j] * rs;
                    h0[j] = g0 * __builtin_amdgcn_rcpf(1.f + __builtin_amdgcn_exp2f(-g0 * LOG2E)) * u0 * wgt;
                    h1[j] = g1 * __builtin_amdgcn_rcpf(1.f + __builtin_amdgcn_exp2f(-g1 * LOG2E)) * u1 * wgt; }
                stg16(u.O, (unsigned)(r * u.ldc) * 2u + lcol, pack8(h0, h1)); }
    }
};
struct EpiDown {
    const f32x4* rinfo; const bf16_t* h2; bf16_t* h3; float* ss;
    __device__ __forceinline__ void operator()(const f32x4 (&acc)[2][2][4][2], const Unit& u, int wr, int wc, int fr, int fq) const {
        const int col0 = u.pn * 256 + wc * 32 + 8 * fq;
#pragma unroll
        for (int ai = 0; ai < 2; ++ai)
#pragma unroll
            for (int m = 0; m < 4; ++m) { const int r = ai * 128 + wr * 64 + m * 16 + fr; const bool valid = r < u.aux1; const int rr = valid ? r : u.aux1 - 1;
                const int tok = __builtin_bit_cast(int, ldg16f(rinfo, (unsigned)(u.aux0 + rr) * 16u).w); float sq = 0.f;
#pragma unroll
                for (int bj = 0; bj < 2; ++bj) { const unsigned eoff = (unsigned)(tok * D + col0 + bj * 128);
                    const u32x4 w = ldg16(h2, eoff * 2u);
                    const f32x4 v0 = acc[ai][bj][m][0] + (f32x4){bflo(w.x), bfhi(w.x), bflo(w.y), bfhi(w.y)}, v1 = acc[ai][bj][m][1] + (f32x4){bflo(w.z), bfhi(w.z), bflo(w.w), bfhi(w.w)};
                    sq += sq8(v0, v1);
                    if (valid) stg16(h3, eoff * 2u, pack8(v0, v1)); }
                sq += __shfl_xor(sq, 16); sq += __shfl_xor(sq, 32);
                if (fq == 0 && valid) *(float*)((char*)ss + (unsigned)(tok * 16 + u.pn * 4 + wc) * 4u) = sq; }
    }
};

#define P2_DMA(gptr, ldsptr) __builtin_amdgcn_global_load_lds((const unsigned*)(gptr), (LAS unsigned*)(ldsptr), 16, 0, 0)
__device__ __forceinline__ void sb_attn_unit(LAS unsigned char* wl, const bf16_t* __restrict__ QKU, const bf16_t* __restrict__ VT, bf16_t* __restrict__ MIX, int u, int lane) {
    asm volatile("" : "+v"(lane));
    const int b = u >> 11, h = (u >> 8) & 7, qg = u & 255, r = lane & 31, hi = lane >> 5;
    const size_t tok0 = (size_t)b * SEQ;
    const char* kg = (const char*)(QKU + tok0 * QKU_LD + 1024 + h * 64);
    const char* vg = (const char*)(VT + (size_t)(h * 64) * NTOK + tok0);
    unsigned kso[4];
#pragma unroll
    for (int i = 0; i < 4; ++i) { const int row = 8 * i + (lane >> 3), c = (lane & 7) ^ ((row >> 1) & 7); kso[i] = (unsigned)(row * (QKU_LD * 2) + c * 16); }
    const unsigned vso = (unsigned)((lane >> 2) * (NTOK * 2) + (((lane & 3) ^ ((lane >> 4) & 3)) * 16));
    const int kperm = (r & 0x13) | ((r & 4) << 1) | ((r & 8) >> 1);
    int kfo[4], vfo[2];
#pragma unroll
    for (int ks = 0; ks < 4; ++ks) kfo[ks] = kperm * 128 + (((2 * ks + hi) ^ ((kperm >> 1) & 7)) * 16);
#pragma unroll
    for (int ks = 0; ks < 2; ++ks) vfo[ks] = r * 64 + (((2 * ks + hi) ^ ((r >> 2) & 3)) * 16);
#define ATT_STAGE(tile, buf) do { const char* kgt = kg + (size_t)(tile) * (32 * QKU_LD * 2); const char* vgt = vg + (size_t)(tile) * 64; \
        _Pragma("unroll") for (int i = 0; i < 4; ++i) P2_DMA(kgt + kso[i], wl + (buf) * 4096 + i * 1024); \
        _Pragma("unroll") for (int i = 0; i < 4; ++i) P2_DMA(vgt + (size_t)i * (16 * NTOK * 2) + vso, wl + 8192 + (buf) * 4096 + i * 1024); } while (0)
    const bf16_t* qp = QKU + (tok0 + qg * 32 + r) * QKU_LD + 512 + h * 64 + 8 * hi;
    bf16x8 qf[4];
#pragma unroll
    for (int ks = 0; ks < 4; ++ks) qf[ks] = *(const bf16x8*)(qp + 16 * ks);
    ATT_STAGE(qg, 0);
    f32x16 o0, o1;
#pragma unroll
    for (int i = 0; i < 16; ++i) { o0[i] = 0.f; o1[i] = 0.f; }
    float carry = 1.f;
    const int t = qg * 32 + r;
    int cur = 0;
    for (int kt = qg;;) {
        const int kn = kt > 0 ? kt - 1 : 0;
        ATT_STAGE(kn, cur ^ 1);
        asm volatile("s_waitcnt vmcnt(8)" ::: "memory");
        LAS unsigned char* kb = wl + cur * 4096; LAS unsigned char* vb = wl + 8192 + cur * 4096;
        bf16x8 kf[4];
#pragma unroll
        for (int ks = 0; ks < 4; ++ks) kf[ks] = *(const LAS bf16x8*)(kb + kfo[ks]);
        const bf16x8 v00 = *(const LAS bf16x8*)(vb + vfo[0]), v01 = *(const LAS bf16x8*)(vb + vfo[1]), v10 = *(const LAS bf16x8*)(vb + 2048 + vfo[0]), v11 = *(const LAS bf16x8*)(vb + 2048 + vfo[1]);
        f32x16 s;
#pragma unroll
        for (int i = 0; i < 16; ++i) s[i] = 0.f;
#pragma unroll
        for (int ks = 0; ks < 4; ++ks) s = MFMA32(kf[ks], qf[ks], s);
        float wt[16];
        const bool diag = (kt == qg);
        float Ta = 1.f, Tb = 1.f;
#pragma unroll
        for (int i = 7; i >= 0; --i) {
            { const int key = kt * 32 + 8 * hi + i; float ee = __builtin_amdgcn_exp2f(fminf(s[i], 100.f)); float rr = __builtin_amdgcn_rcpf(1.f + ee);
              if (diag && key >= t) { ee = 0.f; rr = 1.f; }
              Ta *= rr; wt[i] = ee * Ta; }
            { const int key = kt * 32 + 16 + 8 * hi + i; float ee = __builtin_amdgcn_exp2f(fminf(s[8 + i], 100.f)); float rr = __builtin_amdgcn_rcpf(1.f + ee);
              if (diag && key >= t) { ee = 0.f; rr = 1.f; }
              Tb *= rr; wt[8 + i] = ee * Tb; }
        }
        const float pTa = __shfl_xor(Ta, 32), pTb = __shfl_xor(Tb, 32);
        const float offb = hi ? carry : carry * pTb;
        const float offa = hi ? carry * Tb * pTb : carry * pTb * Tb * pTa;
        carry = carry * ((Ta * Tb) * (pTa * pTb));
        u32x4 w0, w1;
        w0.x = cvtpk(wt[0] * offa, wt[1] * offa); w0.y = cvtpk(wt[2] * offa, wt[3] * offa); w0.z = cvtpk(wt[4] * offa, wt[5] * offa); w0.w = cvtpk(wt[6] * offa, wt[7] * offa);
        w1.x = cvtpk(wt[8] * offb, wt[9] * offb); w1.y = cvtpk(wt[10] * offb, wt[11] * offb); w1.z = cvtpk(wt[12] * offb, wt[13] * offb); w1.w = cvtpk(wt[14] * offb, wt[15] * offb);
        const bf16x8 wa = __builtin_bit_cast(bf16x8, w0), wb = __builtin_bit_cast(bf16x8, w1);
        o0 = MFMA32(v00, wa, o0); o0 = MFMA32(v01, wb, o0); o1 = MFMA32(v10, wa, o1); o1 = MFMA32(v11, wb, o1);
        if (kt == 0 || __all(carry < 7.8e-31f)) break;
        --kt; cur ^= 1;
    }
    asm volatile("s_waitcnt vmcnt(0)" ::: "memory");
#undef ATT_STAGE
    bf16_t* op = MIX + (tok0 + qg * 32 + r) * D + 512 + h * 64 + 4 * hi;
#pragma unroll
    for (int g = 0; g < 4; ++g) { u32x2 a, c; a.x = cvtpk(o0[4 * g], o0[4 * g + 1]); a.y = cvtpk(o0[4 * g + 2], o0[4 * g + 3]); c.x = cvtpk(o1[4 * g], o1[4 * g + 1]); c.y = cvtpk(o1[4 * g + 2], o1[4 * g + 3]);
        *(u32x2*)(op + 8 * g) = a; *(u32x2*)(op + 32 + 8 * g) = c; }
}
template <int G, bool MASKED> __device__ __forceinline__ void pool_unit_g(LAS unsigned char* wl, const bf16_t* __restrict__ QKU, const bf16_t* __restrict__ WPT_, const float* __restrict__ pscale_, bf16_t* __restrict__ MIX, int tg, int lane) {
    constexpr int W = 2 << G;
    asm volatile("" : "+s"(pscale_), "+s"(WPT_), "+v"(lane));
    const GAS float* pscale = (const GAS float*)pscale_; const GAS bf16_t* WPT = (const GAS bf16_t*)WPT_;
    const int r = lane & 31, hi = lane >> 5;
    const int tok0 = tg * 32, tok = tok0 + r, t = tok & (SEQ - 1);
    const int nwin = (t + 1) < W ? (t + 1) : W; const float inv = 1.f / (float)nwin;
    const char* ug = (const char*)(QKU + G * 128);
#pragma unroll
    for (int i = 0; i < 13; ++i) { const int q = i * 64 + lane, j = (q * 3856) >> 16  , p = q - j * 17, c = p < 16 ? p : 0; int row = tok0 - 15 + (j < 47 ? j : 46); row = row < 0 ? 0 : row;
        P2_DMA(ug + (size_t)row * (QKU_LD * 2) + c * 16, wl + i * 1024); }
    const LAS unsigned char* xb = wl + (15 + r - (W - 1)) * 272 + hi * 16;
    const GAS bf16_t* wp = WPT + (size_t)G * 128 * 128 + (size_t)r * 128 + 8 * hi;
    f32x16 acc[4];
#pragma unroll
    for (int mb = 0; mb < 4; ++mb)
#pragma unroll
        for (int i = 0; i < 16; ++i) acc[mb][i] = 0.f;
    bf16x8 a[4][4];
#define POOL_LDA(kb) do { _Pragma("unroll") for (int k = 0; k < 4; ++k) _Pragma("unroll") for (int mb = 0; mb < 4; ++mb) a[k][mb] = *(const GAS bf16x8*)(wp + (size_t)mb * 32 * 128 + 16 * ((kb) + k)); } while (0)
#define POOL_KSTEP(ks, k) do { float sm[8]; _Pragma("unroll") for (int j = 0; j < 8; ++j) sm[j] = 0.f; u32x4 self; \
        _Pragma("unroll") for (int i0 = 0; i0 < W; i0 += 8) { \
        _Pragma("unroll") for (int i = i0; i < (i0 + 8 < W ? i0 + 8 : W); ++i) { const u32x4 x = *(const LAS u32x4*)(xb + (W - 1 - i) * 272 + (ks) * 32); const float m = (!MASKED || i < nwin) ? 1.f : 0.f; \
            if (i == 0) self = x; \
            sm[0] += m * bflo(x.x); sm[1] += m * bfhi(x.x); sm[2] += m * bflo(x.y); sm[3] += m * bfhi(x.y); sm[4] += m * bflo(x.z); sm[5] += m * bfhi(x.z); sm[6] += m * bflo(x.w); sm[7] += m * bfhi(x.w); } \
        if (W > 8) __builtin_amdgcn_sched_barrier(0); } \
        u32x4 o; o.x = cvtpk(sm[0] * inv - bflo(self.x), sm[1] * inv - bfhi(self.x)); o.y = cvtpk(sm[2] * inv - bflo(self.y), sm[3] * inv - bfhi(self.y)); \
        o.z = cvtpk(sm[4] * inv - bflo(self.z), sm[5] * inv - bfhi(self.z)); o.w = cvtpk(sm[6] * inv - bflo(self.w), sm[7] * inv - bfhi(self.w)); \
        const bf16x8 pf = __builtin_bit_cast(bf16x8, o); \
        _Pragma("unroll") for (int mb = 0; mb < 4; ++mb) acc[mb] = MFMA32(a[k][mb], pf, acc[mb]); } while (0)
    if constexpr (MASKED) {
        asm volatile("s_waitcnt vmcnt(0)" ::: "memory");
#pragma unroll
        for (int ks = 0; ks < 8; ++ks) {
#pragma unroll
            for (int mb = 0; mb < 4; ++mb) a[0][mb] = *(const GAS bf16x8*)(wp + (size_t)mb * 32 * 128 + 16 * ks);
            POOL_KSTEP(ks, 0); __builtin_amdgcn_sched_barrier(0);
        }
    } else {
    POOL_LDA(0);
    __builtin_amdgcn_sched_barrier(0);
    asm volatile("s_waitcnt vmcnt(16)" ::: "memory");
    POOL_KSTEP(0, 0); __builtin_amdgcn_sched_barrier(0); POOL_KSTEP(1, 1); __builtin_amdgcn_sched_barrier(0); POOL_KSTEP(2, 2); __builtin_amdgcn_sched_barrier(0); POOL_KSTEP(3, 3);
    __builtin_amdgcn_sched_barrier(0);
    POOL_LDA(4);
    __builtin_amdgcn_sched_barrier(0);
    POOL_KSTEP(4, 0); __builtin_amdgcn_sched_barrier(0); POOL_KSTEP(5, 1); __builtin_amdgcn_sched_barrier(0); POOL_KSTEP(6, 2); __builtin_amdgcn_sched_barrier(0); POOL_KSTEP(7, 3);
    }
#undef POOL_LDA
#undef POOL_KSTEP
    bf16_t* op = MIX + (size_t)tok * D + G * 128 + 4 * hi;
#pragma unroll
    for (int mb = 0; mb < 4; ++mb)
#pragma unroll
        for (int q = 0; q < 4; ++q) { const f32x4 sc = *(const GAS f32x4*)(pscale + G * 128 + mb * 32 + 8 * q + 4 * hi);
            u32x2 o; o.x = cvtpk(acc[mb][4 * q] * sc.x, acc[mb][4 * q + 1] * sc.y); o.y = cvtpk(acc[mb][4 * q + 2] * sc.z, acc[mb][4 * q + 3] * sc.w);
            *(u32x2*)(op + mb * 32 + 8 * q) = o; }
}
__device__ __forceinline__ void pool_unit(LAS unsigned char* wl, const bf16_t* __restrict__ QKU, const bf16_t* __restrict__ WPT, const float* __restrict__ pscale, bf16_t* __restrict__ MIX, int u, int lane) {
    const int tg = u >> 2, g = u & 3;
    if ((tg & (SEQ / 32 - 1)) == 0) {
        if (g == 0) pool_unit_g<0, true>(wl, QKU, WPT, pscale, MIX, tg, lane); else if (g == 1) pool_unit_g<1, true>(wl, QKU, WPT, pscale, MIX, tg, lane);
        else if (g == 2) pool_unit_g<2, true>(wl, QKU, WPT, pscale, MIX, tg, lane); else pool_unit_g<3, true>(wl, QKU, WPT, pscale, MIX, tg, lane);
    } else {
        if (g == 0) pool_unit_g<0, false>(wl, QKU, WPT, pscale, MIX, tg, lane); else if (g == 1) pool_unit_g<1, false>(wl, QKU, WPT, pscale, MIX, tg, lane);
        else if (g == 2) pool_unit_g<2, false>(wl, QKU, WPT, pscale, MIX, tg, lane); else pool_unit_g<3, false>(wl, QKU, WPT, pscale, MIX, tg, lane);
    }
}

constexpr int XROW = 528;
__device__ __forceinline__ void stage256(LAS unsigned char* lds, const bf16_t* src, int ld, int wave, int lane) {
#pragma unroll
    for (int i = 0; i < 17; ++i) {
        const int ins = i * 8 + wave;
        if (ins < 132) { const int j = ins * 64 + lane, R = (j * 1986) >> 16  , pos = j - R * 33, c = pos < 32 ? pos : 0;
            __builtin_amdgcn_global_load_lds((const unsigned*)(src + (size_t)R * ld + c * 8), (LAS unsigned*)(lds + ins * 1024), 16, 0, 0); }
    }
}
__device__ __forceinline__ bf16x8 frag256(LAS unsigned char* lds, int R, int c) { return *(const LAS bf16x8*)(lds + R * XROW + c * 16); }
__device__ __forceinline__ void cross_phase(LAS unsigned char* lds, const bf16_t* __restrict__ QM, const bf16_t* __restrict__ KMEM, const bf16_t* __restrict__ VMT, bf16_t* __restrict__ OC, int vcu, int G, int wave, int lane) {
    const int r = lane & 31, hi = lane >> 5;
    const int kperm = (r & 0x13) | ((r & 4) << 1) | ((r & 8) >> 1);
#pragma unroll 1
    for (int u = vcu; u < (NTOK / 256) * 4; u += G) {
        const int rb = u >> 2, hd = u & 3, tok0 = rb * 256 + wave * 32, b = (rb * 256) >> 13;
        stage256(lds, KMEM + (size_t)(b * 256) * D + hd * 256, D, wave, lane);
        const bf16_t* qp = QM + (size_t)(tok0 + r) * D + hd * 256 + 8 * hi;
        bf16x8 qa[2], qb[2];
#pragma unroll
        for (int k = 0; k < 2; ++k) qa[k] = *(const bf16x8*)(qp + 16 * k);
        VM_WAIT(); __syncthreads();
        f32x16 s[8];
#pragma unroll
        for (int kb = 0; kb < 8; ++kb)
#pragma unroll
            for (int i = 0; i < 16; ++i) s[kb][i] = 0.f;
#define CROSS_S(QF, g) do { _Pragma("unroll") for (int k = 0; k < 2; ++k) _Pragma("unroll") for (int kb = 0; kb < 8; ++kb) { \
            const bf16x8 kf = frag256(lds, kb * 32 + kperm, 2 * ((g) * 2 + k) + hi); s[kb] = MFMA32(kf, QF[k], s[kb]); } } while (0)
#define CROSS_Q(QF, g) do { _Pragma("unroll") for (int k = 0; k < 2; ++k) QF[k] = *(const bf16x8*)(qp + 16 * ((g) * 2 + k)); } while (0)
#define CROSS_STEP(QN, QC, g) do { CROSS_Q(QN, (g) + 1); __builtin_amdgcn_sched_barrier(0); CROSS_S(QC, g); __builtin_amdgcn_sched_barrier(0); } while (0)
        CROSS_STEP(qb, qa, 0); CROSS_STEP(qa, qb, 1); CROSS_STEP(qb, qa, 2); CROSS_STEP(qa, qb, 3); CROSS_STEP(qb, qa, 4); CROSS_STEP(qa, qb, 5); CROSS_STEP(qb, qa, 6);
        CROSS_S(qb, 7);
#undef CROSS_STEP
#undef CROSS_S
#undef CROSS_Q
        float mx = -3.0e38f;
#pragma unroll
        for (int kb = 0; kb < 8; ++kb)
#pragma unroll
            for (int i = 0; i < 16; ++i) mx = fmaxf(mx, s[kb][i]);
        mx = fmaxf(mx, __shfl_xor(mx, 32));
        float sum = 0.f; bf16x8 pf[16];
#pragma unroll
        for (int kb = 0; kb < 8; ++kb) {
            float e[16];
#pragma unroll
            for (int i = 0; i < 16; ++i) { e[i] = __builtin_amdgcn_exp2f(s[kb][i] - mx); sum += e[i]; }
            u32x4 w0, w1; w0.x = cvtpk(e[0], e[1]); w0.y = cvtpk(e[2], e[3]); w0.z = cvtpk(e[4], e[5]); w0.w = cvtpk(e[6], e[7]);
            w1.x = cvtpk(e[8], e[9]); w1.y = cvtpk(e[10], e[11]); w1.z = cvtpk(e[12], e[13]); w1.w = cvtpk(e[14], e[15]);
            pf[2 * kb] = __builtin_bit_cast(bf16x8, w0); pf[2 * kb + 1] = __builtin_bit_cast(bf16x8, w1);
        }
        sum += __shfl_xor(sum, 32);
        const float inv = 1.f / sum;
        __syncthreads();
        stage256(lds, VMT + (size_t)(hd * 256) * 1024 + b * 256, 1024, wave, lane);
        VM_WAIT(); __syncthreads();
        bf16_t* op = OC + (size_t)(tok0 + r) * D + hd * 256 + 4 * hi;
#pragma unroll 1
        for (int dh = 0; dh < 2; ++dh) {
            f32x16 o[4];
#pragma unroll
            for (int db = 0; db < 4; ++db)
#pragma unroll
                for (int i = 0; i < 16; ++i) o[db][i] = 0.f;
#pragma unroll
            for (int ks = 0; ks < 16; ++ks)
#pragma unroll
                for (int db = 0; db < 4; ++db) { const bf16x8 vf = frag256(lds, (dh * 4 + db) * 32 + r, 2 * ks + hi); o[db] = MFMA32(vf, pf[ks], o[db]); }
#pragma unroll
            for (int db = 0; db < 4; ++db)
#pragma unroll
                for (int q = 0; q < 4; ++q) { u32x2 w; w.x = cvtpk(o[db][4 * q] * inv, o[db][4 * q + 1] * inv); w.y = cvtpk(o[db][4 * q + 2] * inv, o[db][4 * q + 3] * inv);
                    *(u32x2*)(op + (dh * 4 + db) * 32 + 8 * q) = w; }
        }
        __syncthreads();
    }
}

constexpr int RPITCH = 2064;
__device__ __forceinline__ void router_stage(LAS unsigned char* lds, const bf16_t* WR, int wave, int lane) {
#pragma unroll
    for (int i = 0; i < 17; ++i) { const int ins = i * 8 + wave;
        if (ins < 129) { const int q = ins * 64 + lane, row = (q * 8129) >> 20  , p = q - row * 129, c = p < 128 ? p : 0;
            __builtin_amdgcn_global_load_lds((const unsigned*)((const char*)WR + (size_t)row * 2048 + c * 16), (LAS unsigned*)(lds + ins * 1024), 16, 0, 0); } }
}
__device__ __forceinline__ void router_unit(LAS unsigned char* lds, const bf16_t* __restrict__ H2, const float* __restrict__ SS2, f32x4* __restrict__ RINFO, unsigned* cntbase, int rg, int lane) {
    asm volatile("" : "+v"(lane));
    const int r = lane & 31, hi = lane >> 5, tok = rg * 32 + r;
    const bf16_t* hp = H2 + (size_t)tok * D + 8 * hi;
    const LAS unsigned char* wh = lds + r * RPITCH + hi * 16; const LAS unsigned char* wl = wh + 32 * RPITCH;
    f32x16 acc[2][2];
#pragma unroll
    for (int a = 0; a < 2; ++a)
#pragma unroll
        for (int c = 0; c < 2; ++c)
#pragma unroll
            for (int i = 0; i < 16; ++i) acc[a][c][i] = 0.f;
    bf16x8 xa[8], xb[8];
#define RT_LDX(X, c) do { _Pragma("unroll") for (int k = 0; k < 8; ++k) X[k] = *(const bf16x8*)(hp + 16 * (8 * (c) + k)); } while (0)
#define RT_MMA(X, c) do { _Pragma("unroll") for (int k = 0; k < 8; ++k) { const int ks = 8 * (c) + k; \
        const bf16x8 fh = *(const LAS bf16x8*)(wh + ks * 32), fl = *(const LAS bf16x8*)(wl + ks * 32); \
        acc[0][k & 1] = MFMA32(fh, X[k], acc[0][k & 1]); acc[1][k & 1] = MFMA32(fl, X[k], acc[1][k & 1]); } } while (0)
#define RT_STEP(XN, XC, c) do { RT_LDX(XN, (c) + 1); __builtin_amdgcn_sched_barrier(0); RT_MMA(XC, c); __builtin_amdgcn_sched_barrier(0); } while (0)
    RT_LDX(xa, 0);
    RT_STEP(xb, xa, 0); RT_STEP(xa, xb, 1); RT_STEP(xb, xa, 2); RT_STEP(xa, xb, 3); RT_STEP(xb, xa, 4); RT_STEP(xa, xb, 5); RT_STEP(xb, xa, 6);
    RT_MMA(xb, 7);
#undef RT_LDX
#undef RT_MMA
#undef RT_STEP
    float lg[12];
#pragma unroll
    for (int i = 0; i < 12; ++i) lg[i] = (acc[0][0][i] + acc[0][1][i]) + (acc[1][0][i] + acc[1][1][i]);
    float xo[8];
#pragma unroll
    for (int i = 0; i < 8; ++i) xo[i] = __shfl_xor(lg[4 + i], 32);
    const float tss = sum16(SS2, (unsigned)tok * 64u);
    const float rs = 1.0f / sqrtf(tss * (1.f / D) + RMS_EPS);
    float gl[4] = {lg[0] * rs, lg[1] * rs, lg[2] * rs, lg[3] * rs};
    int gi = 0; float gm = gl[0];
#pragma unroll
    for (int j = 1; j < 4; ++j) if (gl[j] > gm) { gm = gl[j]; gi = j; }
    float gsum = 0.f;
#pragma unroll
    for (int j = 0; j < 4; ++j) gsum += __builtin_amdgcn_exp2f((gl[j] - gm) * LOG2E);
    const float ggate = 1.f / gsum;
    float el[4];
#pragma unroll
    for (int j = 0; j < 4; ++j) { const float e0 = lg[4 + j], e1 = xo[j], e2 = lg[8 + j], e3 = xo[4 + j]; el[j] = (gi == 0 ? e0 : gi == 1 ? e1 : gi == 2 ? e2 : e3) * rs; }
    int i1 = 0; float m1 = el[0];
#pragma unroll
    for (int j = 1; j < 4; ++j) if (el[j] > m1) { m1 = el[j]; i1 = j; }
    int i2 = -1; float m2 = -3.0e38f;
#pragma unroll
    for (int j = 0; j < 4; ++j) if (j != i1 && el[j] > m2) { m2 = el[j]; i2 = j; }
    const float ex = __builtin_amdgcn_exp2f((m2 - m1) * LOG2E); const float w1 = 1.f / (1.f + ex), w2 = ex * w1;
    const int lo = i1 < i2 ? i1 : i2, hh = i1 < i2 ? i2 : i1;
    const float wlo = ggate * (i1 < i2 ? w1 : w2), whi = ggate * (i1 < i2 ? w2 : w1);
    const int pair = lo == 0 ? hh - 1 : (lo == 1 ? hh + 1 : 5);
    const int combo = gi * 6 + pair;
    const bool owner = (hi == 0);
    unsigned mycnt = 0; unsigned long long mymask = 0ull;
#pragma unroll 1
    for (int cb = 0; cb < NCOMBO; ++cb) {
        const unsigned long long mask = __ballot(owner && combo == cb);
        if (lane == cb) mycnt = (unsigned)__popcll(mask);
        if (owner && combo == cb) mymask = mask;
    }
    unsigned base = 0;
    if (lane < NCOMBO && mycnt) base = __hip_atomic_fetch_add(cntbase + 64 * lane, mycnt, RLX_AGENT);
    const unsigned mybase = (unsigned)__shfl((int)base, combo & 63);
    const int pos = (int)mybase + __popcll(mymask & ((1ull << lane) - 1ull));
    if (owner) RINFO[(size_t)combo * NTOK + pos] = (f32x4){rs, wlo, whi, __builtin_bit_cast(float, tok)};
}
__device__ __forceinline__ void router_phase(LAS unsigned char* lds, const bf16_t* H2, const bf16_t* WR, const float* SS2, f32x4* RINFO, unsigned* cntbase, int G, int wave, int lane) {
    router_stage(lds, WR, wave, lane);
    VM_WAIT(); __syncthreads();
    if (wave < 4) { for (int rg = (int)blockIdx.x * 4 + wave; rg < NTOK / 32; rg += G * 4) router_unit(lds, H2, SS2, RINFO, cntbase, rg, lane); }
    __syncthreads();
}

struct Args { const float* in[20]; float* out; unsigned char* ws; int ph_lo, ph_hi; };
constexpr int N_PHASES = 11;

__global__ void __launch_bounds__(NWAVES * 64, 2) fwd(Args args) {
    extern __shared__ __attribute__((aligned(16))) unsigned char lds_raw[];
    Frame F;
    F.lds = (LAS unsigned char*)lds_raw;
    F.MISC = (volatile LAS unsigned*)(F.lds + LDSCTL_OFF);
    F.tid = threadIdx.x; F.lane = F.tid & 63; F.wave = __builtin_amdgcn_readfirstlane(F.tid >> 6);
    F.G = gridDim.x; { const int bx = blockIdx.x; F.vcu = (F.G % 8 == 0) ? (bx % 8) * (F.G / 8) + bx / 8 : bx; }
    unsigned char* ws = args.ws; F.ws = ws;
    F.ctl = (unsigned*)(ws + WS_CTL);
    for (int u = F.tid; u < (LDS_BYTES - LDSCTL_OFF) / 4; u += NWAVES * 64) ((LAS unsigned*)(F.lds + LDSCTL_OFF))[u] = 0u;
    __syncthreads();
    const int lo = args.ph_lo, hi = args.ph_hi;
    const bool multi = (hi - lo) > 1;
    XcdBarrier bar; bar.bar = F.ctl + CW_BAR; bar.x = 0; bar.st = nullptr;
    if (multi) bar = xcd_barrier_post(F.ctl + CW_BAR, F.MISC + MW_BAR);
#ifndef PHASE_MASK
#define PHASE_MASK 0x7ff
#endif
#define IN(k) (((PHASE_MASK >> (k)) & 1) && lo <= (k) && (k) < hi)
#define SEAM(k) do { if (IN(k) && IN((k) + 1)) xcd_barrier(bar); } while (0)
#ifndef DUP_MASK
#define DUP_MASK 0
#endif
#define REPS(k) ((((DUP_MASK) >> (k)) & 1) ? 2 : 1)
#define DUPBAR(k, rep) do { if (REPS(k) == 2 && (rep) == 0 && multi) xcd_barrier(bar); } while (0)

    bf16_t* const XN = (bf16_t*)(ws + WS_RA);  bf16_t* const MIX = XN; bf16_t* const QM = XN; bf16_t* const H2 = XN;
    bf16_t* const QKU = (bf16_t*)(ws + WS_RB); bf16_t* const VT = (bf16_t*)(ws + WS_VT);
    bf16_t* const H1 = (bf16_t*)(ws + WS_RB);  bf16_t* const OC = (bf16_t*)(ws + WS_OC); bf16_t* const HH = (bf16_t*)(ws + WS_RB);
    const int gw = F.vcu * NWAVES + F.wave, NGW = F.G * NWAVES;

    if (IN(0)) { _Pragma("unroll") for (int rep = 0; rep < REPS(0); ++rep) { p0_prologue(F, args.in); DUPBAR(0, rep); } }
    SEAM(0);
    if (IN(1)) {
        SchedP1 S{(const char*)XN, (const char*)(ws + WS_WIN), (char*)QKU, (char*)VT, F.G, (int)blockIdx.x};
        EpiStore E{nullptr, 1.f};
        _Pragma("unroll") for (int rep = 0; rep < REPS(1); ++rep) { pg8::gemm_phase<EpiStore, SchedP1, false, true>(F.lds, D, D, D, S, E); DUPBAR(1, rep); }
    }
    SEAM(1);
    if (IN(2)) {
        SchedMemKV S{(const char*)(ws + WS_MEMN), (const char*)(ws + WS_WKV), (char*)(ws + WS_KMEM), (char*)(ws + WS_VMT), F.G, (int)blockIdx.x};
        EpiStore E{nullptr, 1.f};
        constexpr int NATT = NB * 8 * 256, NPOOL = (NTOK / 32) * 4;
        pg8::gemm_phase<EpiStore, SchedMemKV, false, true>(F.lds, D, D, D, S, E);
        _Pragma("unroll") for (int rep = 0; rep < REPS(2); ++rep) {
        constexpr int NUNITS = NATT + NPOOL;
        const int nG = F.G < 32 ? F.G : 32, nO = F.G - nG;
        int s0, s1;
        if (F.G == 256) { const int bx = (int)blockIdx.x; s0 = bx < 32 ? bx * P2_SLOTS_GEMM : 32 * P2_SLOTS_GEMM + (bx - 32) * P2_SLOTS_OTHER; s1 = s0 + (bx < 32 ? P2_SLOTS_GEMM : P2_SLOTS_OTHER); }
        else { const int per = (NUNITS + F.G - 1) / F.G; s0 = (int)blockIdx.x * per; s1 = s0 + per < NUNITS ? s0 + per : NUNITS; (void)nO; }
        LAS unsigned* cursor = (LAS unsigned*)(F.lds + LDSCTL_OFF) + MW_CUR + rep;
        for (;;) {
            unsigned idx = 0; if (F.lane == 0) idx = __hip_atomic_fetch_add(cursor, 1u, __ATOMIC_RELAXED, __HIP_MEMORY_SCOPE_WORKGROUP);
            const int slot = s0 + (int)__builtin_amdgcn_readfirstlane(idx);
            if (slot >= s1) break;
            const int tri = slot / 3, ph = slot - tri * 3;
            const unsigned u = ph == 2 ? (unsigned)(NATT + tri) : (unsigned)(2 * tri + ph);
#if defined(DUP_P2_MODE)
            if (rep == 0 && REPS(2) == 2 && ((DUP_P2_MODE == 1 && u >= (unsigned)NATT) || (DUP_P2_MODE == 2 && u < (unsigned)NATT))) continue;
#endif
            if (u < (unsigned)NATT) sb_attn_unit(F.lds + F.wave * 16384, QKU, VT, MIX, (int)u, F.lane);
            else pool_unit(F.lds + F.wave * 16384, QKU, (const bf16_t*)(ws + WS_WP), args.in[I_POOL_SCALE], MIX, (int)u - NATT, F.lane);
        }
        DUPBAR(2, rep); }
    }
    SEAM(2);
    if (IN(3)) {
        SchedStd S{(const char*)MIX, (const char*)(ws + WS_WOUT), nullptr, F.G, (int)blockIdx.x};
        EpiRes<true> E{(const void*)args.in[I_X], H1, (float*)(ws + WS_SS1)};
        _Pragma("unroll") for (int rep = 0; rep < REPS(3); ++rep) { pg8::gemm_phase<EpiRes<true>, SchedStd, false, true>(F.lds, D, D, D, S, E); DUPBAR(3, rep); }
    }
    SEAM(3);
    if (IN(4)) {
        SchedStd S{(const char*)H1, (const char*)(ws + WS_WQ), QM, F.G, (int)blockIdx.x};
        EpiStore E{(const float*)(ws + WS_SS1), QSCALE_MEM};
        _Pragma("unroll") for (int rep = 0; rep < REPS(4); ++rep) { pg8::gemm_phase<EpiStore, SchedStd, false, true>(F.lds, D, D, D, S, E); DUPBAR(4, rep); }
    }
    SEAM(4);
    if (IN(5)) {
        _Pragma("unroll") for (int rep = 0; rep < REPS(5); ++rep) { cross_phase(F.lds, QM, (const bf16_t*)(ws + WS_KMEM), (const bf16_t*)(ws + WS_VMT), OC, F.vcu, F.G, F.wave, F.lane); DUPBAR(5, rep); }
    }
    SEAM(5);
    if (IN(6)) {
        SchedStd S{(const char*)OC, (const char*)(ws + WS_WO), nullptr, F.G, (int)blockIdx.x};
        EpiRes<false> E{(const void*)H1, H2, (float*)(ws + WS_SS2)};
        _Pragma("unroll") for (int rep = 0; rep < REPS(6); ++rep) { pg8::gemm_phase<EpiRes<false>, SchedStd, false, true>(F.lds, D, D, D, S, E); DUPBAR(6, rep); }
    }
    SEAM(6);
    if (IN(7)) {
#if ((DUP_MASK) >> 7) & 1
        router_phase(F.lds, H2, (const bf16_t*)(ws + WS_WR), (const float*)(ws + WS_SS2), (f32x4*)(ws + WS_RB), F.ctl + 65536, F.G, F.wave, F.lane);
        if (multi) xcd_barrier(bar);
#endif
        router_phase(F.lds, H2, (const bf16_t*)(ws + WS_WR), (const float*)(ws + WS_SS2), (f32x4*)(ws + WS_RINFO), F.ctl + CW_CNT, F.G, F.wave, F.lane);
    }
    SEAM(7);
    if (IN(8) || IN(9)) {
        __syncthreads();
        int t2 = F.tid; asm volatile("" : "+v"(t2));
        if (t2 < NCOMBO) F.MISC[MW_CNT + t2] = __hip_atomic_load(F.ctl + CW_CNT + 64 * t2, RLX_AGENT);
        __syncthreads();
        if (F.tid == 0) { unsigned acc = 0; for (int k = 0; k < NCOMBO; ++k) { F.MISC[MW_TP + k] = acc; acc += (F.MISC[MW_CNT + k] + 255u) >> 8; } F.MISC[MW_TP + NCOMBO] = acc; }
        __syncthreads();
    }
    if (IN(8)) {
        SchedP8 S{F.MISC, (const char*)H2, (const char*)(ws + WS_GU), (char*)HH, (const f32x4*)(ws + WS_RINFO), F.G, F.vcu};
        EpiGU E{(const f32x4*)(ws + WS_RINFO)};
        _Pragma("unroll") for (int rep = 0; rep < REPS(8); ++rep) { pg8::gemm_phase<EpiGU, SchedP8, true, true>(F.lds, D, D, D, S, E); DUPBAR(8, rep); }
    }
    SEAM(8);
    if (IN(9)) {
        SchedP9 S{F.MISC, (const char*)HH, (const char*)(ws + WS_WD), F.G, F.vcu};
        EpiDown E{(const f32x4*)(ws + WS_RINFO), H2, (bf16_t*)(ws + WS_H3), (float*)(ws + WS_SS3)};
        _Pragma("unroll") for (int rep = 0; rep < REPS(9); ++rep) { pg8::gemm_phase<EpiDown, SchedP9, false, true>(F.lds, D, 512, 512, S, E); DUPBAR(9, rep); }
    }
    SEAM(9);
    if (IN(10)) {
        const float* ss3 = (const float*)(ws + WS_SS3);
        _Pragma("unroll") for (int rep = 0; rep < REPS(10); ++rep) {
        const bool real = (rep == REPS(10) - 1);
        const bf16_t* h3 = (const bf16_t*)(ws + WS_H3);
        for (int m = gw * 4; m < NTOK; m += NGW * 4) {
            u32x4 v[4][2]; float rs[4];
#pragma unroll
            for (int q = 0; q < 4; ++q) { const u32x4* p = (const u32x4*)(h3 + (size_t)(m + q) * D) + F.lane; v[q][0] = p[0]; v[q][1] = p[64]; }
#pragma unroll
            for (int q = 0; q < 4; ++q) { const float t = sum16(ss3, (unsigned)(m + q) * 64u); rs[q] = real ? 1.0f / sqrtf(t * (1.f / D) + RMS_EPS) : 1.f + 0.f * t; }
            f32x4 g[2][2];
#pragma unroll
            for (int hh = 0; hh < 2; ++hh) { const f32x4* gp = (const f32x4*)args.in[I_NORM_FINAL] + hh * 128 + 2 * F.lane; g[hh][0] = gp[0]; g[hh][1] = gp[1]; }
#pragma unroll
            for (int q = 0; q < 4; ++q)
#pragma unroll
                for (int hh = 0; hh < 2; ++hh) { const u32x4 w = v[q][hh]; const float r = rs[q]; f32x4* o = (f32x4*)(args.out + (size_t)(m + q) * D + hh * 512) + 2 * F.lane;
                    o[0] = (f32x4){bflo(w.x) * r * g[hh][0].x, bfhi(w.x) * r * g[hh][0].y, bflo(w.y) * r * g[hh][0].z, bfhi(w.y) * r * g[hh][0].w};
                    o[1] = (f32x4){bflo(w.z) * r * g[hh][1].x, bfhi(w.z) * r * g[hh][1].y, bflo(w.w) * r * g[hh][1].z, bfhi(w.w) * r * g[hh][1].w}; }
        }
        DUPBAR(10, rep); }
    }
#undef IN
#undef SEAM
}

extern "C" void kernel_launch(void* const* d_in, const int* in_sizes, int n_in, void* d_out, int out_size, void* d_ws, size_t ws_size, hipStream_t stream) {
    static int grid = 0;
    if (grid == 0) {
        if (n_in != 20 || in_sizes[0] != NTOK * D || out_size != NTOK * D || ws_size < WS_END) { fprintf(stderr, "kernel_launch: unexpected shapes (n_in %d, in0 %d, out %d, ws %zu); nothing launched\n", n_in, n_in > 0 ? in_sizes[0] : -1, out_size, ws_size); grid = -1; return; }
        int dev = 0, cus = 0, per_cu = 0;
        if (hipGetDevice(&dev) != hipSuccess || hipDeviceGetAttribute(&cus, hipDeviceAttributeMultiprocessorCount, dev) != hipSuccess) { grid = -1; return; }
        if (hipFuncSetAttribute((const void*)fwd, hipFuncAttributeMaxDynamicSharedMemorySize, LDS_BYTES) != hipSuccess) { fprintf(stderr, "kernel_launch: hipFuncSetAttribute failed\n"); grid = -1; return; }
        if (hipOccupancyMaxActiveBlocksPerMultiprocessor(&per_cu, (const void*)fwd, NWAVES * 64, LDS_BYTES) != hipSuccess || per_cu < 1) { fprintf(stderr, "kernel_launch: occupancy query reports %d blocks per CU\n", per_cu); }
        (void)hipGetLastError();
        grid = cus;
    }
    if (grid < 0) return;
    if (hipMemsetAsync((char*)d_ws + WS_CTL, 0, CTL_ZERO_BYTES, stream) != hipSuccess) return;
    Args a{};
    for (int i = 0; i < 20; ++i) a.in[i] = (const float*)d_in[i];
    a.out = (float*)d_out; a.ws = (unsigned char*)d_ws;
    if (MK_N_LAUNCHES == 1) { a.ph_lo = 0; a.ph_hi = N_PHASES; hipLaunchKernelGGL(fwd, dim3(grid), dim3(NWAVES * 64), LDS_BYTES, stream, a); }
    else { for (int p = 0; p < N_PHASES; ++p) { a.ph_lo = p; a.ph_hi = p + 1; hipLaunchKernelGGL(fwd, dim3(grid), dim3(NWAVES * 64), LDS_BYTES, stream, a); } }
}
```
